# Optimizing an MI355X kernel written in HIP

```python
import jax, jax.numpy as jnp
from jax import lax
import numpy as np

D_MODEL = 2048
BATCH = 4
SEQ = 2048
DEPTH = 1
DEC_BATCH = 128
DEC_SEQ = 8
PAST_LEN = 16384
PAGE_SIZE = 128

D_MIX = D_MODEL
LRU_WIDTH = D_MIX // 2
LRU_HEADS = 8
LRU_HEAD_DIM = LRU_WIDTH // LRU_HEADS
LRU_C = 8.0
CONV_WIDTH = 4
SGU_WIDTH = D_MIX - LRU_WIDTH
SGU_HEADS = 8
SGU_HEAD_DIM = SGU_WIDTH // SGU_HEADS
CHUNK = 128
PROJ_WIDTH = 2 * LRU_WIDTH + 3 * SGU_WIDTH
EPS = 1e-6

kernel_name = "hymba_rglru_chunk_sgu_decode_step"


def rms_norm(x, g):
    xf = x.astype(jnp.float32)
    y = xf * lax.rsqrt(jnp.mean(xf * xf, axis=-1, keepdims=True) + EPS)
    return (y * g.astype(jnp.float32)).astype(x.dtype)


def causal_depthwise_conv(xb, buf, w, b):
    T = xb.shape[1]
    xp = jnp.concatenate([buf.astype(xb.dtype), xb], axis=1)
    y = b + xp[:, 0:T] * w[0]
    for k in range(1, CONV_WIDTH):
        y = y + xp[:, k:k + T] * w[k]
    return y, xp[:, -(CONV_WIDTH - 1):]


def rg_lru(x, reset, h0, w_r, b_r, w_i, b_i, lam):
    N, T, W = x.shape
    xh = x.reshape(N, T, LRU_HEADS, LRU_HEAD_DIM)
    r = jax.nn.sigmoid(jnp.einsum('nthi,hij->nthj', xh, w_r) + b_r).reshape(N, T, W).astype(jnp.float32)
    i = jax.nn.sigmoid(jnp.einsum('nthi,hij->nthj', xh, w_i) + b_i).reshape(N, T, W).astype(jnp.float32)
    log_a = -LRU_C * r * jax.nn.softplus(-lam.astype(jnp.float32))
    a = jnp.exp(log_a)
    mult = jnp.sqrt(-jnp.expm1(2.0 * log_a))
    rs = reset[None, :, None]
    mult = jnp.where(rs, 1.0, mult)
    a = jnp.where(rs, 0.0, a)
    bterm = mult * i * x.astype(jnp.float32)
    bterm = bterm.at[:, 0].add(a[:, 0] * h0.astype(jnp.float32))

    def combine(c1, c2):
        a1, b1 = c1
        a2, b2 = c2
        return a1 * a2, a2 * b1 + b2

    _, h = lax.associative_scan(combine, (a, bterm), axis=1)
    return h.astype(x.dtype), h[:, -1].astype(h0.dtype)


def chunk_spatial_gating(u, v, w_s, b_s):
    N, T, W = u.shape
    L = min(T, CHUNK)
    n_chunks = T // L
    mask = jnp.tril(jnp.ones((L, L), dtype=bool))
    ws = jnp.where(mask[None], w_s[:, :L, :L], 0.0).astype(v.dtype)
    vc = v.reshape(N, n_chunks, L, SGU_HEADS, SGU_HEAD_DIM)
    s = jnp.einsum('hts,ncshd->ncthd', ws, vc) + b_s[:, :L].T[None, None, :, :, None]
    return u * s.reshape(N, T, W)


def mixer_layer(x, pos0, conv_buf, h0, pre_g, post_g, w_in, conv_w, conv_b,
                w_r, b_r, w_i, b_i, lam, sgu_g, w_s, b_s, w_out):
    T = x.shape[1]
    z = rms_norm(x, pre_g)
    proj = z @ w_in
    o1 = LRU_WIDTH
    o2 = o1 + LRU_WIDTH
    o3 = o2 + SGU_WIDTH
    o4 = o3 + SGU_WIDTH
    xr, gr, u, v, gs = (proj[..., :o1], proj[..., o1:o2], proj[..., o2:o3],
                        proj[..., o3:o4], proj[..., o4:])
    xc, new_buf = causal_depthwise_conv(xr, conv_buf, conv_w, conv_b)
    reset = (pos0 + jnp.arange(T)) == 0
    hr, h_last = rg_lru(xc, reset, h0, w_r, b_r, w_i, b_i, lam)
    br = hr * jax.nn.silu(gr)
    u = jax.nn.gelu(u)
    v = rms_norm(jax.nn.gelu(v), sgu_g)
    bs = chunk_spatial_gating(u, v, w_s, b_s) * jax.nn.silu(gs)
    out = jnp.concatenate([br, bs], axis=-1) @ w_out
    y = x + rms_norm(out, post_g)
    return y, new_buf, h_last, v


def setup_inputs(seed: int = 0) -> dict:
    key = jax.random.key(seed)
    ks = jax.random.split(key, 20)
    f32 = jnp.float32
    a_c = jax.random.uniform(ks[9], (DEPTH, LRU_WIDTH), f32, 0.9, 0.999)
    a = a_c ** (1.0 / LRU_C)
    lam = jnp.log(a) - jnp.log1p(-a)
    return {
        "x_prompt": jax.random.normal(ks[0], (BATCH, SEQ, D_MODEL), f32),
        "x_sample": jax.random.normal(ks[1], (DEC_BATCH, DEC_SEQ, D_MODEL), f32),
        "state_rglru_conv": jax.random.normal(ks[2], (DEPTH, DEC_BATCH, CONV_WIDTH - 1, LRU_WIDTH), f32),
        "state_rglru_h": 0.5 * jax.random.normal(ks[3], (DEPTH, DEC_BATCH, LRU_WIDTH), f32),
        "pre_norm_g": 1.0 + 0.02 * jax.random.normal(ks[4], (DEPTH, D_MODEL), f32),
        "post_norm_g": 1.0 + 0.02 * jax.random.normal(ks[5], (DEPTH, D_MODEL), f32),
        "w_in": jax.random.normal(ks[6], (DEPTH, D_MODEL, PROJ_WIDTH), f32) * D_MODEL ** -0.5,
        "conv_w": jax.random.normal(ks[7], (DEPTH, CONV_WIDTH, LRU_WIDTH), f32) * CONV_WIDTH ** -0.5,
        "conv_b": 0.01 * jax.random.normal(ks[8], (DEPTH, LRU_WIDTH), f32),
        "w_rgate": jax.random.normal(ks[10], (DEPTH, LRU_HEADS, LRU_HEAD_DIM, LRU_HEAD_DIM), f32) * LRU_HEAD_DIM ** -0.5,
        "b_rgate": 0.01 * jax.random.normal(ks[11], (DEPTH, LRU_HEADS, LRU_HEAD_DIM), f32),
        "w_igate": jax.random.normal(ks[12], (DEPTH, LRU_HEADS, LRU_HEAD_DIM, LRU_HEAD_DIM), f32) * LRU_HEAD_DIM ** -0.5,
        "b_igate": 0.01 * jax.random.normal(ks[13], (DEPTH, LRU_HEADS, LRU_HEAD_DIM), f32),
        "lru_lambda": lam,
        "sgu_norm_g": 1.0 + 0.02 * jax.random.normal(ks[14], (DEPTH, SGU_WIDTH), f32),
        "w_spatial": jax.random.normal(ks[15], (DEPTH, SGU_HEADS, CHUNK, CHUNK), f32) * CHUNK ** -0.5,
        "b_spatial": 1.0 + 0.02 * jax.random.normal(ks[16], (DEPTH, SGU_HEADS, CHUNK), f32),
        "w_out": jax.random.normal(ks[17], (DEPTH, D_MIX, D_MODEL), f32) * D_MIX ** -0.5,
    }


def reference(x_prompt, x_sample, state_rglru_conv, state_rglru_h, pre_norm_g, post_norm_g,
              w_in, conv_w, conv_b, w_rgate, b_rgate, w_igate, b_igate, lru_lambda,
              sgu_norm_g, w_spatial, b_spatial, w_out):
    yp = x_prompt
    ys = x_sample
    conv_p, h_p, conv_s, h_s, v_s = [], [], [], [], []
    for l in range(DEPTH):
        params = (pre_norm_g[l], post_norm_g[l], w_in[l], conv_w[l], conv_b[l],
                  w_rgate[l], b_rgate[l], w_igate[l], b_igate[l], lru_lambda[l],
                  sgu_norm_g[l], w_spatial[l], b_spatial[l], w_out[l])
        buf0 = jnp.zeros((yp.shape[0], CONV_WIDTH - 1, LRU_WIDTH), yp.dtype)
        hz = jnp.zeros((yp.shape[0], LRU_WIDTH), state_rglru_h.dtype)
        yp, cb_p, hl_p, _ = mixer_layer(yp, 0, buf0, hz, *params)
        ys, cb_s, hl_s, vs = mixer_layer(ys, PAST_LEN, state_rglru_conv[l], state_rglru_h[l], *params)
        conv_p.append(cb_p)
        h_p.append(hl_p)
        conv_s.append(cb_s)
        h_s.append(hl_s)
        v_s.append(vs)
    return (yp, ys, jnp.stack(conv_p), jnp.stack(h_p), jnp.stack(conv_s), jnp.stack(h_s), jnp.stack(v_s))
```

```cpp
#include <hip/hip_runtime.h>
#include <hip/hip_cooperative_groups.h>
#include <cstdio>
namespace cg = cooperative_groups;

#ifndef N_LAUNCHES
#define N_LAUNCHES 6
#endif

#define LAS __attribute__((address_space(3)))
typedef unsigned short bf16_t;
typedef short bf16x8 __attribute__((ext_vector_type(8)));
typedef float f32x4 __attribute__((ext_vector_type(4)));
typedef float f32x2 __attribute__((ext_vector_type(2)));
typedef unsigned u32x4 __attribute__((ext_vector_type(4)));
typedef unsigned u32x2 __attribute__((ext_vector_type(2)));

constexpr int D_MODEL = 2048, MP = 8192  , MS = 1024  , MT = MP + MS, PW = 5120, LW = 1024, SW = 1024;
constexpr int NGRP = MT / 128  , NGRP_P = MP / 128  ;
constexpr float EPS = 1e-6f;
constexpr size_t O_Y = 0, O_CONVP = (size_t)MT * D_MODEL, O_HP = O_CONVP + 4 * 3 * 1024, O_CONVS = O_HP + 4 * 1024, O_HS = O_CONVS + 128 * 3 * 1024, O_V = O_HS + 128 * 1024;
constexpr size_t WS_ZB = 0;
constexpr size_t WS_BT1 = WS_ZB + (size_t)MT * 2048 * 2;
constexpr size_t WS_BT2 = WS_BT1 + (size_t)PW * 2048 * 2;
constexpr size_t WS_SEC = WS_BT2 + (size_t)2048 * 2048 * 2;
constexpr size_t SEC_STRIDE = (size_t)MT * 1024;
constexpr size_t WS_A2 = WS_SEC + 5 * SEC_STRIDE * 2;
constexpr size_t WS_VSS = WS_A2 + (size_t)MT * 2048 * 2;
constexpr size_t WS_OSS = WS_VSS + (size_t)MT * 16 * 4;
constexpr size_t WS_AGG = WS_OSS + (size_t)MT * 32 * 4;
constexpr size_t WS_WRT = WS_AGG + (size_t)64 * 8 * 256 * 4;
constexpr size_t WS_WIT = WS_WRT + (size_t)8 * 128 * 128 * 2;
constexpr size_t WS_END = WS_WIT + (size_t)8 * 128 * 128 * 2;

struct Params {
    const float* in[18];
    float* out;
    unsigned char* ws;
    int ph_lo, ph_hi;
};

__device__ __forceinline__ unsigned cvt_pk_bf16(float lo, float hi) { unsigned r; asm volatile("v_cvt_pk_bf16_f32 %0, %1, %2" : "=v"(r) : "v"(lo), "v"(hi)); return r; }
__device__ __forceinline__ float bf_lo(unsigned w) { return __uint_as_float(w << 16); }
__device__ __forceinline__ float bf_hi(unsigned w) { return __uint_as_float(w & 0xffff0000u); }
__device__ __forceinline__ float fast_rcp(float x) { return __builtin_amdgcn_rcpf(x); }
__device__ __forceinline__ float fast_exp2(float x) { return __builtin_amdgcn_exp2f(x); }
__device__ __forceinline__ float sigmoidf_(float x) { return fast_rcp(1.0f + fast_exp2(-1.44269504f * x)); }
__device__ __forceinline__ float act_gate(float x, float ka, float kb) { return x * fast_rcp(1.0f + fast_exp2(x * (ka + kb * x * x))); }

namespace pg8 {
constexpr int BM = 256, BK = 64, HALF = 128, HTB = HALF * BK * 2, STAGE_BYTES = 8 * HTB, NXCD = 8, WGM = 8;
__host__ __device__ __forceinline__ int lds_byte(int r, int c) { const int st = (r >> 4) * 2 + (c >> 5), rr = r & 15, cc = c & 31, ob = rr * 64 + cc * 2; return st * 1024 + (ob ^ (((ob >> 9) & 1) << 5)); }
__host__ __device__ __forceinline__ void stage_rc(int b, int& R, int& C) { const int st = b / 1024, sb = b % 1024, swz = sb ^ (((sb >> 9) & 1) << 5); R = (st >> 1) * 16 + swz / 64; C = (st & 1) * 32 + (swz % 64) / 2; }
__host__ __device__ __forceinline__ int perm32(int rho) { const int n = rho >> 4, i = rho & 15; return 8 * (i >> 2) + 4 * n + (i & 3); }
struct Unit { int pm, pn; };
struct Gemm { const bf16_t* A; const bf16_t* Bt; int M, N, K; };
struct StaticOrder {
    int nM, nN, nwg, G, c;
    __host__ __device__ void init(int M, int N, int G_, int c_) { nM = M / BM; nN = N / BM; nwg = nM * nN; G = G_; c = c_; }
    __host__ __device__ bool next(int i, Unit& u) const {
        const long L = (long)i * G + c; if (L >= nwg) return false;
        int wgid = (int)L; { const int q = nwg / NXCD, r = nwg % NXCD, xcd = wgid % NXCD, off = wgid / NXCD; wgid = (xcd < r ? xcd * (q + 1) : r * (q + 1) + (xcd - r) * q) + off; }
        const int nig = WGM * nN, gid = wgid / nig, fm = gid * WGM, gsz = (nM - fm) < WGM ? (nM - fm) : WGM;
        u.pm = fm + ((wgid % nig) % gsz); u.pn = (wgid % nig) / gsz; return true;
    }
    __device__ __forceinline__ void a_ready(const Unit&) const {}
    __device__ __forceinline__ void done(const Unit&) const {}
};

struct EpiProj {
    static constexpr bool PERM = true, AFTER_DRAIN = false;
    bf16_t* sec; float* vss;
    __device__ __forceinline__ void operator()(const f32x4 (&acc)[2][2][4][2], const Unit& u, int wr, int wc, int fr, int fq) const {
        const int s = u.pn >> 2, ct = u.pn & 3;
        bf16_t* base = sec + (size_t)s * SEC_STRIDE;
        const int row0 = u.pm * BM + wr * 64 + fr, col0 = ct * 256 + wc * 32 + 8 * fq;
        const bool is_gelu = (s == 2 || s == 3);
        const float ka = is_gelu ? -2.30220819f : -1.44269504f, kb = is_gelu ? -0.10294324f : 0.0f;
#pragma unroll
        for (int ai = 0; ai < 2; ++ai)
#pragma unroll
            for (int m = 0; m < 4; ++m) {
                const int row = row0 + ai * HALF + m * 16;
                bf16_t* rowp = base + (size_t)row * 1024 + col0;
                float ss = 0.f;
#pragma unroll
                for (int bj = 0; bj < 2; ++bj) {
                    f32x4 v0 = acc[ai][bj][m][0], v1 = acc[ai][bj][m][1];
                    if (s != 0) {
#pragma unroll
                        for (int j = 0; j < 4; ++j) { v0[j] = act_gate(v0[j], ka, kb); v1[j] = act_gate(v1[j], ka, kb); }
                    }
                    ss += (v0[0] * v0[0] + v0[1] * v0[1]) + (v0[2] * v0[2] + v0[3] * v0[3]) + (v1[0] * v1[0] + v1[1] * v1[1]) + (v1[2] * v1[2] + v1[3] * v1[3]);
                    u32x4 w; w.x = cvt_pk_bf16(v0[0], v0[1]); w.y = cvt_pk_bf16(v0[2], v0[3]); w.z = cvt_pk_bf16(v1[0], v1[1]); w.w = cvt_pk_bf16(v1[2], v1[3]);
                    *(u32x4*)(rowp + bj * HALF) = w;
                }
                if (s == 3) {
                    ss += __shfl_xor(ss, 16); ss += __shfl_xor(ss, 32);
                    if (fq == 0) vss[(size_t)row * 16 + ct * 4 + wc] = ss;
                }
            }
    }
};
struct EpiOut {
    static constexpr bool PERM = true, AFTER_DRAIN = false;
    bf16_t* O; float* oss;
    __device__ __forceinline__ void operator()(const f32x4 (&acc)[2][2][4][2], const Unit& u, int wr, int wc, int fr, int fq) const {
        const int row0 = u.pm * BM + wr * 64 + fr, col0 = u.pn * BM + wc * 32 + 8 * fq;
#pragma unroll
        for (int ai = 0; ai < 2; ++ai)
#pragma unroll
            for (int m = 0; m < 4; ++m) {
                const int row = row0 + ai * HALF + m * 16;
                bf16_t* rowp = O + (size_t)row * 2048 + col0;
                float ss = 0.f;
#pragma unroll
                for (int bj = 0; bj < 2; ++bj) {
                    const f32x4 v0 = acc[ai][bj][m][0], v1 = acc[ai][bj][m][1];
                    ss += (v0[0] * v0[0] + v0[1] * v0[1]) + (v0[2] * v0[2] + v0[3] * v0[3]) + (v1[0] * v1[0] + v1[1] * v1[1]) + (v1[2] * v1[2] + v1[3] * v1[3]);
                    u32x4 w; w.x = cvt_pk_bf16(v0[0], v0[1]); w.y = cvt_pk_bf16(v0[2], v0[3]); w.z = cvt_pk_bf16(v1[0], v1[1]); w.w = cvt_pk_bf16(v1[2], v1[3]);
                    *(u32x4*)(rowp + bj * HALF) = w;
                }
                ss += __shfl_xor(ss, 16); ss += __shfl_xor(ss, 32);
                if (fq == 0) oss[(size_t)row * 32 + u.pn * 4 + wc] = ss;
            }
    }
};

template <class Epi, class Sched>
__device__ __forceinline__ void gemm_phase(LAS unsigned char* lds, const Gemm g, const Sched& S, const Epi& E) {
    const int tid = threadIdx.x, wid = __builtin_amdgcn_readfirstlane(tid >> 6), lane = tid & 63, wr = wid >> 2, wc = wid & 3, fr = lane & 15, fq = lane >> 4;
    const int K = g.K, nt = K / BK;
    unsigned voffA[2], voffB[2];
#pragma unroll
    for (int i = 0; i < 2; ++i) { int R, C; stage_rc(tid * 16 + i * 8192, R, C); const int Rb = Epi::PERM ? ((R & ~31) + perm32(R & 31)) : R;
        voffA[i] = (unsigned)(R * K + C) * 2u; voffB[i] = (unsigned)(Rb * K + C) * 2u; }
    const size_t kstep = (size_t)(BK * 2);
    const size_t hstep = (size_t)HALF * K * 2;
    const size_t tstep = 2 * hstep;
    const unsigned ldsw = (unsigned)wid * 1024u;
    const int aoff = lds_byte(wr * 64 + fr, fq * 8), boff = lds_byte(wc * 32 + fr, fq * 8);
#define PG8_SA(b, h) (((b) * 2 + (h)) * HTB)
#define PG8_SB(b, h) ((4 + (b) * 2 + (h)) * HTB)
#define PG8_STAGE(bufoff, gbase, voff) do { _Pragma("unroll") for (int _i = 0; _i < 2; ++_i) \
        __builtin_amdgcn_global_load_lds((const unsigned*)((const char*)(gbase) + (voff)[_i]), (LAS unsigned*)(lds + (bufoff) + ldsw + _i * 8192), 16, 0, 0); } while (0)
#define PG8_LDA(dst, b, h) do { _Pragma("unroll") for (int m = 0; m < 4; ++m) _Pragma("unroll") for (int k = 0; k < 2; ++k) dst[m][k] = *(const LAS bf16x8*)(lds + PG8_SA(b, h) + aoff + m * 2048 + k * 1024); } while (0)
#define PG8_LDB(dst, b, h) do { _Pragma("unroll") for (int n = 0; n < 2; ++n) _Pragma("unroll") for (int k = 0; k < 2; ++k) dst[n][k] = *(const LAS bf16x8*)(lds + PG8_SB(b, h) + boff + n * 2048 + k * 1024); } while (0)
#define PG8_MMA(ai, bj, At, Bt) do { __builtin_amdgcn_s_setprio(1); _Pragma("unroll") for (int m = 0; m < 4; ++m) _Pragma("unroll") for (int n = 0; n < 2; ++n) _Pragma("unroll") for (int k = 0; k < 2; ++k) \
        acc[ai][bj][m][n] = __builtin_amdgcn_mfma_f32_16x16x32_bf16(Bt[n][k], At[m][k], acc[ai][bj][m][n], 0, 0, 0); __builtin_amdgcn_s_setprio(0); } while (0)
#define PG8_WAIT_V(n) asm volatile("s_waitcnt vmcnt(" #n ")" ::: "memory")
#define PG8_WAIT_L(n) asm volatile("s_waitcnt lgkmcnt(" #n ")" ::: "memory")
#define PG8_BAR __builtin_amdgcn_s_barrier()
#define PG8_SCHED __builtin_amdgcn_sched_barrier(0)
    Unit cur, nxt; int ui = 0;
    if (!S.next(0, cur)) return;
    f32x4 acc[2][2][4][2];
#pragma unroll
    for (int a = 0; a < 2; ++a)
#pragma unroll
        for (int b = 0; b < 2; ++b)
#pragma unroll
            for (int m = 0; m < 4; ++m)
#pragma unroll
                for (int n = 0; n < 2; ++n) acc[a][b][m][n] = (f32x4){0.f, 0.f, 0.f, 0.f};
    bf16x8 At[4][2], B0[2][2], B1[2][2];
    const char* cA = (const char*)g.A + (size_t)cur.pm * tstep; const char* cB = (const char*)g.Bt + (size_t)cur.pn * tstep;
    S.a_ready(cur);
    PG8_STAGE(PG8_SB(0, 0), cB, voffB); PG8_STAGE(PG8_SA(0, 0), cA, voffA); PG8_STAGE(PG8_SB(0, 1), cB + hstep, voffB); PG8_STAGE(PG8_SA(0, 1), cA + hstep, voffA);
    if (wr == 1) PG8_BAR;
    PG8_WAIT_V(4); PG8_BAR;
    PG8_STAGE(PG8_SB(1, 0), cB + kstep, voffB); PG8_STAGE(PG8_SA(1, 0), cA + kstep, voffA); PG8_STAGE(PG8_SB(1, 1), cB + hstep + kstep, voffB);
    PG8_WAIT_V(6); PG8_BAR;
    for (;;) {
        const bool has_next = S.next(ui + 1, nxt);
        const char* nA = has_next ? (const char*)g.A + (size_t)nxt.pm * tstep : cA; const char* nB = has_next ? (const char*)g.Bt + (size_t)nxt.pn * tstep : cB;
        for (int t = 0; t < nt; t += 2) {
            const bool last = (t == nt - 2);
            const char* a1 = cA + (size_t)(t + 1) * kstep;
            const char* a2 = last ? nA : cA + (size_t)(t + 2) * kstep; const char* b2 = last ? nB : cB + (size_t)(t + 2) * kstep;
            const char* a3 = a2 + kstep; const char* b3 = b2 + kstep;
            if (last && has_next) S.a_ready(nxt);
            PG8_LDB(B0, 0, 0); PG8_SCHED; PG8_LDA(At, 0, 0); PG8_STAGE(PG8_SA(1, 1), a1 + hstep, voffA);
            PG8_WAIT_L(8); PG8_BAR; PG8_WAIT_L(0); PG8_MMA(0, 0, At, B0); PG8_BAR; PG8_SCHED;
            PG8_LDB(B1, 0, 1); PG8_STAGE(PG8_SB(0, 0), b2, voffB);
            PG8_BAR; PG8_WAIT_L(0); PG8_MMA(0, 1, At, B1); PG8_BAR;
            PG8_LDA(At, 0, 1); PG8_STAGE(PG8_SA(0, 0), a2, voffA);
            PG8_BAR; PG8_WAIT_L(0); PG8_MMA(1, 0, At, B0); PG8_BAR; PG8_SCHED;
            PG8_STAGE(PG8_SB(0, 1), b2 + hstep, voffB);
            PG8_WAIT_V(6); PG8_BAR; PG8_MMA(1, 1, At, B1); PG8_BAR;
            PG8_LDB(B0, 1, 0); PG8_SCHED; PG8_LDA(At, 1, 0); PG8_STAGE(PG8_SA(0, 1), a2 + hstep, voffA);
            PG8_WAIT_L(8); PG8_BAR; PG8_WAIT_L(0); PG8_MMA(0, 0, At, B0); PG8_BAR; PG8_SCHED;
            PG8_LDB(B1, 1, 1); PG8_STAGE(PG8_SB(1, 0), b3, voffB);
            PG8_BAR; PG8_WAIT_L(0); PG8_MMA(0, 1, At, B1); PG8_BAR;
            PG8_LDA(At, 1, 1); PG8_STAGE(PG8_SA(1, 0), a3, voffA);
            PG8_BAR; PG8_WAIT_L(0); PG8_MMA(1, 0, At, B0); PG8_BAR; PG8_SCHED;
            PG8_STAGE(PG8_SB(1, 1), b3 + hstep, voffB);
            PG8_WAIT_V(6); PG8_BAR; PG8_MMA(1, 1, At, B1); PG8_BAR;
        }
        if constexpr (!Epi::AFTER_DRAIN) { E(acc, cur, wr, wc, fr, fq); S.done(cur); }
        if (!has_next) break;
#pragma unroll
        for (int a = 0; a < 2; ++a)
#pragma unroll
            for (int b = 0; b < 2; ++b)
#pragma unroll
                for (int m = 0; m < 4; ++m)
#pragma unroll
                    for (int n = 0; n < 2; ++n) acc[a][b][m][n] = (f32x4){0.f, 0.f, 0.f, 0.f};
        cur = nxt; cA = nA; cB = nB; ++ui;
    }
    PG8_WAIT_V(0);
    if (wr == 0) PG8_BAR;
    PG8_BAR;
#undef PG8_SA
#undef PG8_SB
#undef PG8_STAGE
#undef PG8_LDA
#undef PG8_LDB
#undef PG8_MMA
#undef PG8_WAIT_V
#undef PG8_WAIT_L
#undef PG8_BAR
#undef PG8_SCHED
}
}

__device__ __forceinline__ void p0_prep(const Params& p, LAS unsigned char* lds) {
    const int tid = threadIdx.x, lane = tid & 63, wid = tid >> 6;
    unsigned char* ws = p.ws;
    {
        LAS float* T = (LAS float*)lds;
        const int nt1 = 32 * 80, nt2 = 32 * 32;
        for (int tile = blockIdx.x; tile < nt1 + nt2; tile += gridDim.x) {
            const float* src; bf16_t* dst; int ldn, kt, ntile;
            if (tile < nt1) { src = p.in[6]; dst = (bf16_t*)(ws + WS_BT1); ldn = PW; kt = tile / 80; ntile = tile % 80; }
            else { const int t2 = tile - nt1; src = p.in[17]; dst = (bf16_t*)(ws + WS_BT2); ldn = 2048; kt = t2 / 32; ntile = t2 % 32; }
            const int k0 = kt * 64, n0 = ntile * 64;
#pragma unroll
            for (int i = 0; i < 2; ++i) {
                const int k = (tid >> 4) + 32 * i, n4 = (tid & 15) * 4;
                const f32x4 v = *(const f32x4*)(src + (size_t)(k0 + k) * ldn + n0 + n4);
                T[k * 65 + n4 + 0] = v[0]; T[k * 65 + n4 + 1] = v[1]; T[k * 65 + n4 + 2] = v[2]; T[k * 65 + n4 + 3] = v[3];
            }
            __syncthreads();
            {
                const int n = tid >> 3, k8 = (tid & 7) * 8;
                float f[8];
#pragma unroll
                for (int i = 0; i < 8; ++i) f[i] = T[(k8 + i) * 65 + n];
                u32x4 w; w.x = cvt_pk_bf16(f[0], f[1]); w.y = cvt_pk_bf16(f[2], f[3]); w.z = cvt_pk_bf16(f[4], f[5]); w.w = cvt_pk_bf16(f[6], f[7]);
                *(u32x4*)(dst + (size_t)(n0 + n) * 2048 + k0 + k8) = w;
            }
            __syncthreads();
        }
    }
    {
        const int total = 2 * 8 * 16 * 128;
        for (int idx = blockIdx.x * 512 + tid; idx < total; idx += gridDim.x * 512) {
            const int j = idx & 127, k8 = (idx >> 7) & 15, h = (idx >> 11) & 7, which = idx >> 14;
            const float* w = (which ? p.in[11] : p.in[9]) + (size_t)h * 128 * 128;
            float f[8];
#pragma unroll
            for (int i = 0; i < 8; ++i) f[i] = w[(k8 * 8 + i) * 128 + j];
            u32x4 o; o.x = cvt_pk_bf16(f[0], f[1]); o.y = cvt_pk_bf16(f[2], f[3]); o.z = cvt_pk_bf16(f[4], f[5]); o.w = cvt_pk_bf16(f[6], f[7]);
            bf16_t* dst = (bf16_t*)(ws + (which ? WS_WIT : WS_WRT));
            *(u32x4*)(dst + ((size_t)h * 128 + j) * 128 + k8 * 8) = o;
        }
    }
    {
        bf16_t* zb = (bf16_t*)(ws + WS_ZB);
        const float* gpre = p.in[4];
        for (int row = blockIdx.x * 8 + wid; row < MT; row += gridDim.x * 8) {
            const float* xr = row < MP ? p.in[0] + (size_t)row * 2048 : p.in[1] + (size_t)(row - MP) * 2048;
            f32x4 v[8]; float ss = 0.f;
#pragma unroll
            for (int i = 0; i < 8; ++i) { v[i] = *(const f32x4*)(xr + (lane + 64 * i) * 4); ss += (v[i][0] * v[i][0] + v[i][1] * v[i][1]) + (v[i][2] * v[i][2] + v[i][3] * v[i][3]); }
#pragma unroll
            for (int o = 32; o >= 1; o >>= 1) ss += __shfl_xor(ss, o);
            const float rs = rsqrtf(ss * (1.0f / 2048.0f) + EPS);
#pragma unroll
            for (int i = 0; i < 8; ++i) {
                const f32x4 gg = *(const f32x4*)(gpre + (lane + 64 * i) * 4);
                u32x2 w; w.x = cvt_pk_bf16(v[i][0] * rs * gg[0], v[i][1] * rs * gg[1]); w.y = cvt_pk_bf16(v[i][2] * rs * gg[2], v[i][3] * rs * gg[3]);
                *(u32x2*)(zb + (size_t)row * 2048 + (lane + 64 * i) * 4) = w;
            }
        }
    }
}

constexpr int XCB_LD = 136, XCF_LD = 132, XCF_OFF = 128 * XCB_LD * 2;
template <int PASS>
__device__ __forceinline__ void lru_unit(const Params& p, LAS unsigned char* lds, int g, int h) {
    const int tid = threadIdx.x, lane = tid & 63, wid = __builtin_amdgcn_readfirstlane(tid >> 6), fr = lane & 15, fq = lane >> 4;
    unsigned char* ws = p.ws;
    const bf16_t* XR = (const bf16_t*)(ws + WS_SEC);
    const bf16_t* SGR = XR + SEC_STRIDE;
    bf16_t* A2 = (bf16_t*)(ws + WS_A2);
    float* AGG = (float*)(ws + WS_AGG);
    LAS bf16_t* XCB = (LAS bf16_t*)lds;
    LAS float* XCF = (LAS float*)(lds + XCF_OFF);
    const int row0 = g * 128, ch0 = h * 128;
    const bool samp = g >= NGRP_P;
    const int c = g & 15, nseq = g >> 4;
    const int ns0 = (g - NGRP_P) * 16;
    {
        const int c8 = (tid & 15) * 8;
        float cw[4][8], cb[8];
#pragma unroll
        for (int k = 0; k < 4; ++k) { const f32x4 a = *(const f32x4*)(p.in[7] + k * 1024 + ch0 + c8), b = *(const f32x4*)(p.in[7] + k * 1024 + ch0 + c8 + 4);
            cw[k][0] = a[0]; cw[k][1] = a[1]; cw[k][2] = a[2]; cw[k][3] = a[3]; cw[k][4] = b[0]; cw[k][5] = b[1]; cw[k][6] = b[2]; cw[k][7] = b[3]; }
        { const f32x4 a = *(const f32x4*)(p.in[8] + ch0 + c8), b = *(const f32x4*)(p.in[8] + ch0 + c8 + 4);
            cb[0] = a[0]; cb[1] = a[1]; cb[2] = a[2]; cb[3] = a[3]; cb[4] = b[0]; cb[5] = b[1]; cb[6] = b[2]; cb[7] = b[3]; }
#pragma unroll 1
        for (int it = 0; it < 4; ++it) {
            const int r = (tid >> 4) + 32 * it;
            float acc[8];
#pragma unroll
            for (int i = 0; i < 8; ++i) acc[i] = cb[i];
#pragma unroll
            for (int d = 0; d < 4; ++d) {
                float xv[8];
                bool from_x; int tt;
                if (!samp) { tt = c * 128 + r - d; from_x = tt >= 0; } else { tt = (r & 7) - d; from_x = tt >= 0; }
                if (from_x) {
                    const u32x4 w = *(const u32x4*)(XR + (size_t)(row0 + r - d) * 1024 + ch0 + c8);
                    xv[0] = bf_lo(w.x); xv[1] = bf_hi(w.x); xv[2] = bf_lo(w.y); xv[3] = bf_hi(w.y); xv[4] = bf_lo(w.z); xv[5] = bf_hi(w.z); xv[6] = bf_lo(w.w); xv[7] = bf_hi(w.w);
                } else if (samp) {
                    const float* st = p.in[2] + ((size_t)(ns0 + (r >> 3)) * 3 + (3 + tt)) * 1024 + ch0 + c8;
                    const f32x4 a = *(const f32x4*)st, b = *(const f32x4*)(st + 4);
                    xv[0] = a[0]; xv[1] = a[1]; xv[2] = a[2]; xv[3] = a[3]; xv[4] = b[0]; xv[5] = b[1]; xv[6] = b[2]; xv[7] = b[3];
                } else {
#pragma unroll
                    for (int i = 0; i < 8; ++i) xv[i] = 0.f;
                }
#pragma unroll
                for (int i = 0; i < 8; ++i) acc[i] += cw[3 - d][i] * xv[i];
                if (PASS == 2 && d == 0) {
                    float* dst = nullptr;
                    if (!samp) { if (c == 15 && r >= 125) dst = p.out + O_CONVP + ((size_t)nseq * 3 + (r - 125)) * 1024 + ch0 + c8; }
                    else { if ((r & 7) >= 5) dst = p.out + O_CONVS + ((size_t)(ns0 + (r >> 3)) * 3 + ((r & 7) - 5)) * 1024 + ch0 + c8; }
                    if (dst) { *(f32x4*)dst = (f32x4){xv[0], xv[1], xv[2], xv[3]}; *(f32x4*)(dst + 4) = (f32x4){xv[4], xv[5], xv[6], xv[7]}; }
                }
            }
            u32x4 w; w.x = cvt_pk_bf16(acc[0], acc[1]); w.y = cvt_pk_bf16(acc[2], acc[3]); w.z = cvt_pk_bf16(acc[4], acc[5]); w.w = cvt_pk_bf16(acc[6], acc[7]);
            *(LAS u32x4*)(XCB + r * XCB_LD + c8) = w;
            *(LAS f32x4*)(XCF + r * XCF_LD + c8) = (f32x4){acc[0], acc[1], acc[2], acc[3]};
            *(LAS f32x4*)(XCF + r * XCF_LD + c8 + 4) = (f32x4){acc[4], acc[5], acc[6], acc[7]};
        }
    }
    __syncthreads();
    const int chl = 16 * wid + fr, ch = ch0 + chl;
    f32x4 ar[8], ai[8];
#pragma unroll
    for (int m = 0; m < 8; ++m) { ar[m] = (f32x4){0.f, 0.f, 0.f, 0.f}; ai[m] = (f32x4){0.f, 0.f, 0.f, 0.f}; }
    {
        const bf16_t* WRT = (const bf16_t*)(ws + WS_WRT) + ((size_t)h * 128 + chl) * 128 + 8 * fq;
        const bf16_t* WIT = (const bf16_t*)(ws + WS_WIT) + ((size_t)h * 128 + chl) * 128 + 8 * fq;
        bf16x8 br[4], bi[4];
#pragma unroll
        for (int ks = 0; ks < 4; ++ks) { br[ks] = *(const bf16x8*)(WRT + 32 * ks); bi[ks] = *(const bf16x8*)(WIT + 32 * ks); }
#pragma unroll
        for (int m = 0; m < 8; ++m)
#pragma unroll
            for (int ks = 0; ks < 4; ++ks) {
                const bf16x8 a = *(const LAS bf16x8*)(XCB + (16 * m + fr) * XCB_LD + 32 * ks + 8 * fq);
                ar[m] = __builtin_amdgcn_mfma_f32_16x16x32_bf16(a, br[ks], ar[m], 0, 0, 0);
                ai[m] = __builtin_amdgcn_mfma_f32_16x16x32_bf16(a, bi[ks], ai[m], 0, 0, 0);
            }
    }
    const float b_r = p.in[10][ch], b_i = p.in[12][ch];
    float sp8;
    { const float nl = -p.in[13][ch]; sp8 = 8.0f * (fmaxf(nl, 0.f) + log1pf(__expf(-fabsf(nl)))); }
    float H = 0.f, Ptot = 1.f;
    if (PASS == 2 && !samp) {
        for (int cc = 0; cc < c; ++cc) {
            const float* a = AGG + ((size_t)((nseq * 16 + cc) * 8 + h)) * 256 + chl;
            H = a[128] + a[0] * H;
        }
    }
#pragma unroll
    for (int m = 0; m < 8; ++m) {
        float pa[4], pb[4];
#pragma unroll
        for (int j = 0; j < 4; ++j) {
            const int t = 16 * m + 4 * fq + j;
            const float rr = sigmoidf_(ar[m][j] + b_r), ii = sigmoidf_(ai[m][j] + b_i);
            const float la = -sp8 * rr;
            float a = __expf(la), mult = sqrtf(-expm1f(2.0f * la));
            const float xc = XCF[t * XCF_LD + chl];
            if (!samp) { if (c == 0 && t == 0) { a = 0.f; mult = 1.f; } }
            float b = mult * ii * xc;
            if (samp && (t & 7) == 0) { b += a * p.in[3][(size_t)(ns0 + (t >> 3)) * 1024 + ch]; a = 0.f; }
            if (j == 0) { pa[0] = a; pb[0] = b; } else { pa[j] = a * pa[j - 1]; pb[j] = a * pb[j - 1] + b; }
        }
        float Ai = pa[3], Bi = pb[3];
        { const float sa = __shfl_up(Ai, 16), sb = __shfl_up(Bi, 16); if (fq >= 1) { Bi = Ai * sb + Bi; Ai = sa * Ai; } }
        { const float sa = __shfl_up(Ai, 32), sb = __shfl_up(Bi, 32); if (fq >= 2) { Bi = Ai * sb + Bi; Ai = sa * Ai; } }
        float ea = __shfl_up(Ai, 16), eb = __shfl_up(Bi, 16); if (fq == 0) { ea = 1.f; eb = 0.f; }
        const float hs = eb + ea * H;
        if (PASS == 2) {
#pragma unroll
            for (int j = 0; j < 4; ++j) XCF[(16 * m + 4 * fq + j) * XCF_LD + chl] = pb[j] + pa[j] * hs;
        }
        const float ta = __shfl(Ai, fr + 48), tb = __shfl(Bi, fr + 48);
        H = tb + ta * H; Ptot *= ta;
    }
    if (PASS == 1) {
        if (fq == 0) { float* a = AGG + ((size_t)(g * 8 + h)) * 256 + chl; a[0] = Ptot; a[128] = H; }
        __syncthreads();
        return;
    }
    __syncthreads();
    {
        const int c8 = (tid & 15) * 8;
#pragma unroll 1
        for (int it = 0; it < 4; ++it) {
            const int r = (tid >> 4) + 32 * it;
            const f32x4 h0 = *(const LAS f32x4*)(XCF + r * XCF_LD + c8), h1 = *(const LAS f32x4*)(XCF + r * XCF_LD + c8 + 4);
            const u32x4 gw = *(const u32x4*)(SGR + (size_t)(row0 + r) * 1024 + ch0 + c8);
            u32x4 w; w.x = cvt_pk_bf16(h0[0] * bf_lo(gw.x), h0[1] * bf_hi(gw.x)); w.y = cvt_pk_bf16(h0[2] * bf_lo(gw.y), h0[3] * bf_hi(gw.y));
            w.z = cvt_pk_bf16(h1[0] * bf_lo(gw.z), h1[1] * bf_hi(gw.z)); w.w = cvt_pk_bf16(h1[2] * bf_lo(gw.w), h1[3] * bf_hi(gw.w));
            *(u32x4*)(A2 + (size_t)(row0 + r) * 2048 + ch0 + c8) = w;
            float* dst = nullptr;
            if (!samp) { if (c == 15 && r == 127) dst = p.out + O_HP + (size_t)nseq * 1024 + ch0 + c8; }
            else { if ((r & 7) == 7) dst = p.out + O_HS + (size_t)(ns0 + (r >> 3)) * 1024 + ch0 + c8; }
            if (dst) { *(f32x4*)dst = h0; *(f32x4*)(dst + 4) = h1; }
        }
    }
    __syncthreads();
}

__device__ __forceinline__ void sgu_unit(const Params& p, LAS unsigned char* lds, int g, int h) {
    const int tid = threadIdx.x, lane = tid & 63, wid = __builtin_amdgcn_readfirstlane(tid >> 6), fr = lane & 15, fq = lane >> 4;
    unsigned char* ws = p.ws;
    const bf16_t* GU = (const bf16_t*)(ws + WS_SEC) + 2 * SEC_STRIDE;
    const bf16_t* GV = GU + SEC_STRIDE;
    const bf16_t* SGS = GV + SEC_STRIDE;
    const float* VSS = (const float*)(ws + WS_VSS);
    bf16_t* A2 = (bf16_t*)(ws + WS_A2);
    LAS bf16_t* WM = (LAS bf16_t*)lds;
    LAS bf16_t* VT = (LAS bf16_t*)(lds + 34816);
    LAS float* RSTD = (LAS float*)(lds + 69632);
    const int row0 = g * 128, d0 = h * 128;
    const bool samp = g >= NGRP_P;
    if (tid < 128) {
        const float* q = VSS + (size_t)(row0 + tid) * 16;
        const f32x4 a = *(const f32x4*)q, b = *(const f32x4*)(q + 4), c = *(const f32x4*)(q + 8), d = *(const f32x4*)(q + 12);
        const float s = ((a[0] + a[1]) + (a[2] + a[3])) + ((b[0] + b[1]) + (b[2] + b[3])) + ((c[0] + c[1]) + (c[2] + c[3])) + ((d[0] + d[1]) + (d[2] + d[3]));
        RSTD[tid] = rsqrtf(s * (1.0f / 1024.0f) + EPS);
    }
    {
        const int s8 = (tid & 15) * 8;
        const float* wsp = p.in[15] + (size_t)h * 128 * 128;
#pragma unroll 1
        for (int it = 0; it < 4; ++it) {
            const int t = (tid >> 4) + 32 * it;
            float f[8];
            if (!samp) {
                const f32x4 a = *(const f32x4*)(wsp + t * 128 + s8), b = *(const f32x4*)(wsp + t * 128 + s8 + 4);
                f[0] = a[0]; f[1] = a[1]; f[2] = a[2]; f[3] = a[3]; f[4] = b[0]; f[5] = b[1]; f[6] = b[2]; f[7] = b[3];
#pragma unroll
                for (int i = 0; i < 8; ++i) f[i] = (s8 + i <= t) ? f[i] : 0.f;
            } else {
                const bool blk = (s8 >> 3) == (t >> 3);
#pragma unroll
                for (int i = 0; i < 8; ++i) f[i] = (blk && i <= (t & 7)) ? wsp[(t & 7) * 128 + i] : 0.f;
            }
            u32x4 w; w.x = cvt_pk_bf16(f[0], f[1]); w.y = cvt_pk_bf16(f[2], f[3]); w.z = cvt_pk_bf16(f[4], f[5]); w.w = cvt_pk_bf16(f[6], f[7]);
            *(LAS u32x4*)(WM + t * 136 + s8) = w;
        }
    }
    __syncthreads();
    {
        const int d8 = (tid & 15) * 8;
        const f32x4 g0 = *(const f32x4*)(p.in[14] + d0 + d8), g1 = *(const f32x4*)(p.in[14] + d0 + d8 + 4);
        const float gg[8] = {g0[0], g0[1], g0[2], g0[3], g1[0], g1[1], g1[2], g1[3]};
#pragma unroll 1
        for (int it = 0; it < 4; ++it) {
            const int s = (tid >> 4) + 32 * it;
            const u32x4 w = *(const u32x4*)(GV + (size_t)(row0 + s) * 1024 + d0 + d8);
            const float rs = RSTD[s];
            float f[8] = {bf_lo(w.x), bf_hi(w.x), bf_lo(w.y), bf_hi(w.y), bf_lo(w.z), bf_hi(w.z), bf_lo(w.w), bf_hi(w.w)};
#pragma unroll
            for (int i = 0; i < 8; ++i) f[i] = f[i] * rs * gg[i];
            if (samp) {
                float* dst = p.out + O_V + (size_t)(row0 - MP + s) * 1024 + d0 + d8;
                *(f32x4*)dst = (f32x4){f[0], f[1], f[2], f[3]}; *(f32x4*)(dst + 4) = (f32x4){f[4], f[5], f[6], f[7]};
            }
#pragma unroll
            for (int i = 0; i < 8; i += 2) { const unsigned pk = cvt_pk_bf16(f[i], f[i + 1]); VT[(d8 + i) * 136 + s] = (bf16_t)(pk & 0xffffu); VT[(d8 + i + 1) * 136 + s] = (bf16_t)(pk >> 16); }
        }
    }
    __syncthreads();
    f32x4 acc[8];
#pragma unroll
    for (int n = 0; n < 8; ++n) acc[n] = (f32x4){0.f, 0.f, 0.f, 0.f};
    const int ksmax = wid >> 1;
    for (int ks = 0; ks <= ksmax; ++ks) {
        const bf16x8 wfrag = *(const LAS bf16x8*)(WM + (16 * wid + fr) * 136 + 32 * ks + 8 * fq);
#pragma unroll
        for (int n = 0; n < 8; ++n) {
            const bf16x8 vfrag = *(const LAS bf16x8*)(VT + (16 * n + fr) * 136 + 32 * ks + 8 * fq);
            acc[n] = __builtin_amdgcn_mfma_f32_16x16x32_bf16(vfrag, wfrag, acc[n], 0, 0, 0);
        }
    }
    {
        const int t = 16 * wid + fr, row = row0 + t;
        const float bias = p.in[16][h * 128 + (samp ? (t & 7) : t)];
#pragma unroll
        for (int n = 0; n < 8; ++n) {
            const int col = d0 + 16 * n + 4 * fq;
            const u32x2 gu = *(const u32x2*)(GU + (size_t)row * 1024 + col), sg = *(const u32x2*)(SGS + (size_t)row * 1024 + col);
            u32x2 w;
            w.x = cvt_pk_bf16((acc[n][0] + bias) * bf_lo(gu.x) * bf_lo(sg.x), (acc[n][1] + bias) * bf_hi(gu.x) * bf_hi(sg.x));
            w.y = cvt_pk_bf16((acc[n][2] + bias) * bf_lo(gu.y) * bf_lo(sg.y), (acc[n][3] + bias) * bf_hi(gu.y) * bf_hi(sg.y));
            *(u32x2*)(A2 + (size_t)row * 2048 + 1024 + col) = w;
        }
    }
    __syncthreads();
}

__device__ __forceinline__ void p5_final(const Params& p) {
    const int tid = threadIdx.x, lane = tid & 63, wid = tid >> 6;
    const bf16_t* OB = (const bf16_t*)(p.ws + WS_ZB);
    const float* OSS = (const float*)(p.ws + WS_OSS);
    const float* gpost = p.in[5];
    for (int row = blockIdx.x * 8 + wid; row < MT; row += gridDim.x * 8) {
        float ss = (lane < 32) ? OSS[(size_t)row * 32 + lane] : 0.f;
#pragma unroll
        for (int o = 32; o >= 1; o >>= 1) ss += __shfl_xor(ss, o);
        const float rs = rsqrtf(ss * (1.0f / 2048.0f) + EPS);
        const float* xr = row < MP ? p.in[0] + (size_t)row * 2048 : p.in[1] + (size_t)(row - MP) * 2048;
        float* yr = p.out + O_Y + (size_t)row * 2048;
#pragma unroll
        for (int i = 0; i < 4; ++i) {
            const int col = (lane + 64 * i) * 8;
            const u32x4 o = *(const u32x4*)(OB + (size_t)row * 2048 + col);
            const f32x4 x0 = *(const f32x4*)(xr + col), x1 = *(const f32x4*)(xr + col + 4), g0 = *(const f32x4*)(gpost + col), g1 = *(const f32x4*)(gpost + col + 4);
            f32x4 y0, y1;
            y0[0] = x0[0] + bf_lo(o.x) * rs * g0[0]; y0[1] = x0[1] + bf_hi(o.x) * rs * g0[1]; y0[2] = x0[2] + bf_lo(o.y) * rs * g0[2]; y0[3] = x0[3] + bf_hi(o.y) * rs * g0[3];
            y1[0] = x1[0] + bf_lo(o.z) * rs * g1[0]; y1[1] = x1[1] + bf_hi(o.z) * rs * g1[1]; y1[2] = x1[2] + bf_lo(o.w) * rs * g1[2]; y1[3] = x1[3] + bf_hi(o.w) * rs * g1[3];
            *(f32x4*)(yr + col) = y0; *(f32x4*)(yr + col + 4) = y1;
        }
    }
}

constexpr int LDS_BYTES = pg8::STAGE_BYTES;
__global__ void __launch_bounds__(512, 2) hymba_fwd(Params p) {
    extern __shared__ __attribute__((aligned(16))) unsigned char shm[];
    LAS unsigned char* lds = (LAS unsigned char*)shm;
    cg::grid_group grid = cg::this_grid();
    const int lo = p.ph_lo, hi = p.ph_hi;
#define IN(k) (lo <= (k) && (k) < hi)
#define SEAM(k) do { if (IN(k) && IN((k) + 1)) grid.sync(); } while (0)
    if (IN(0)) { p0_prep(p, lds); }
    SEAM(0);
    if (IN(1)) {
        pg8::Gemm g{(const bf16_t*)(p.ws + WS_ZB), (const bf16_t*)(p.ws + WS_BT1), MT, PW, 2048};
        pg8::StaticOrder S; S.init(MT, PW, (int)gridDim.x, (int)blockIdx.x);
        pg8::EpiProj E{(bf16_t*)(p.ws + WS_SEC), (float*)(p.ws + WS_VSS)};
        pg8::gemm_phase<pg8::EpiProj, pg8::StaticOrder>(lds, g, S, E);
    }
    SEAM(1);
    if (IN(2)) {
        const int nu = NGRP_P * 8 + NGRP * 8;
        for (int u = blockIdx.x; u < nu; u += gridDim.x) {
            if (u < NGRP_P * 8) lru_unit<1>(p, lds, u >> 3, u & 7);
            else { const int v = u - NGRP_P * 8; sgu_unit(p, lds, v >> 3, v & 7); }
        }
    }
    SEAM(2);
    if (IN(3)) {
        for (int u = blockIdx.x; u < NGRP * 8; u += gridDim.x) lru_unit<2>(p, lds, u >> 3, u & 7);
    }
    SEAM(3);
    if (IN(4)) {
        pg8::Gemm g{(const bf16_t*)(p.ws + WS_A2), (const bf16_t*)(p.ws + WS_BT2), MT, 2048, 2048};
        pg8::StaticOrder S; S.init(MT, 2048, (int)gridDim.x, (int)blockIdx.x);
        pg8::EpiOut E{(bf16_t*)(p.ws + WS_ZB), (float*)(p.ws + WS_OSS)};
        pg8::gemm_phase<pg8::EpiOut, pg8::StaticOrder>(lds, g, S, E);
    }
    SEAM(4);
    if (IN(5)) { p5_final(p); }
#undef IN
#undef SEAM
}

extern "C" void kernel_launch(void* const* d_in, const int* in_sizes, int n_in, void* d_out, int out_size, void* d_ws, size_t ws_size, hipStream_t stream) {
    static int grid = 0;
    if (grid == 0) {
        int dev = 0, cus = 0, per_cu = 0;
        if (n_in != 18 || ws_size < WS_END) { fprintf(stderr, "kernel_launch: unexpected problem (n_in %d, ws %zu < %zu)\n", n_in, ws_size, (size_t)WS_END); grid = -1; return; }
        hipGetDevice(&dev);
        hipDeviceGetAttribute(&cus, hipDeviceAttributeMultiprocessorCount, dev);
        if (hipFuncSetAttribute((const void*)hymba_fwd, hipFuncAttributeMaxDynamicSharedMemorySize, LDS_BYTES) != hipSuccess) { fprintf(stderr, "kernel_launch: hipFuncSetAttribute failed\n"); grid = -1; return; }
        hipOccupancyMaxActiveBlocksPerMultiprocessor(&per_cu, (const void*)hymba_fwd, 512, LDS_BYTES);
        if (per_cu < 1) { fprintf(stderr, "kernel_launch: occupancy query says %d blocks per CU\n", per_cu); per_cu = 1; }
        (void)hipGetLastError();
        grid = cus;
    }
    if (grid < 0) return;
    Params p{};
    for (int i = 0; i < 18; ++i) p.in[i] = (const float*)d_in[i];
    p.out = (float*)d_out; p.ws = (unsigned char*)d_ws;
#if N_LAUNCHES == 1
    p.ph_lo = 0; p.ph_hi = 6;
    void* args[] = {&p};
    hipError_t e = hipLaunchCooperativeKernel((const void*)hymba_fwd, dim3(grid), dim3(512), args, LDS_BYTES, stream);
    if (e != hipSuccess) fprintf(stderr, "cooperative launch failed: %s (grid %d)\n", hipGetErrorString(e), grid);
#else
    for (int k = 0; k < 6; ++k) {
        p.ph_lo = k; p.ph_hi = k + 1;
        hipLaunchKernelGGL(hymba_fwd, dim3(grid), dim3(512), LDS_BYTES, stream, p);
    }
#endif
}
```

```cpp
#include <hip/hip_runtime.h>
#include <cstdio>

#ifndef N_LAUNCHES
#define N_LAUNCHES 1
#endif

#ifndef LRU_FUSED
#define LRU_FUSED 1
#endif
#define LAS __attribute__((address_space(3)))
typedef unsigned short bf16_t;
typedef short bf16x8 __attribute__((ext_vector_type(8)));
typedef short s16x4 __attribute__((ext_vector_type(4)));
typedef float f32x4 __attribute__((ext_vector_type(4)));
typedef float f32x2 __attribute__((ext_vector_type(2)));
typedef unsigned u32x4 __attribute__((ext_vector_type(4)));
typedef unsigned u32x2 __attribute__((ext_vector_type(2)));

constexpr int D_MODEL = 2048, MP = 8192  , MS = 1024  , MT = MP + MS, PW = 5120, LW = 1024, SW = 1024;
constexpr int NGRP = MT / 128  , NGRP_P = MP / 128  ;
constexpr float EPS = 1e-6f;
constexpr size_t O_Y = 0, O_CONVP = (size_t)MT * D_MODEL, O_HP = O_CONVP + 4 * 3 * 1024, O_CONVS = O_HP + 4 * 1024, O_HS = O_CONVS + 128 * 3 * 1024, O_V = O_HS + 128 * 1024;
constexpr size_t WS_ZB = 0;
constexpr size_t WS_BT1 = WS_ZB + (size_t)MT * 2048 * 2;
constexpr size_t WS_BT2 = WS_BT1 + (size_t)PW * 2048 * 2;
constexpr size_t WS_SEC = WS_BT2 + (size_t)2048 * 2048 * 2;
constexpr size_t SEC_STRIDE = (size_t)MT * 1024;
constexpr size_t WS_A2 = WS_ZB;
constexpr size_t WS_OUTB = WS_SEC;
constexpr size_t WS_VSS = WS_SEC + 5 * SEC_STRIDE * 2;
constexpr size_t WS_OSS = WS_VSS + (size_t)MT * 16 * 4;
constexpr size_t WS_WRT = WS_OSS + (size_t)MT * 32 * 4;
constexpr size_t WS_WIT = WS_WRT + (size_t)8 * 128 * 128 * 2;
constexpr size_t WS_WMP = WS_WIT + (size_t)8 * 128 * 128 * 2;
constexpr size_t WS_WMS = WS_WMP + (size_t)8 * 128 * 128 * 2;
constexpr size_t WS_AB = WS_WMS + (size_t)8 * 128 * 128 * 2;
constexpr size_t WS_BAR = WS_AB + (size_t)MP * 1024 * 4;
constexpr size_t WS_AGG = WS_BAR + 16384;
constexpr size_t WS_END = WS_AGG + (size_t)64 * 8 * 128 * 8;

struct Params {
    const float* in[18];
    float* out;
    unsigned char* ws;
    int ph_lo, ph_hi;
};

__device__ __forceinline__ unsigned cvt_pk_bf16(float lo, float hi) { unsigned r; asm("v_cvt_pk_bf16_f32 %0, %1, %2" : "=v"(r) : "v"(lo), "v"(hi)); return r; }
__device__ __forceinline__ float bf_lo(unsigned w) { return __uint_as_float(w << 16); }
__device__ __forceinline__ float bf_hi(unsigned w) { return __uint_as_float(w & 0xffff0000u); }
__device__ __forceinline__ float fast_rcp(float x) { return __builtin_amdgcn_rcpf(x); }
__device__ __forceinline__ float fast_exp2(float x) { return __builtin_amdgcn_exp2f(x); }
__device__ __forceinline__ float sigmoidf_(float x) { return fast_rcp(1.0f + fast_exp2(-1.44269504f * x)); }
__device__ __forceinline__ float act_gate(float x, float ka, float kb) { return x * fast_rcp(1.0f + fast_exp2(x * (ka + kb * x * x))); }


__device__ __forceinline__ f32x2 act_gate2(f32x2 x, float ka, float kb) {
    const f32x2 y = x * (x * x * kb + ka);
    f32x2 e; e.x = fast_exp2(y.x); e.y = fast_exp2(y.y);
    const f32x2 d = e + 1.0f;
    f32x2 r; r.x = fast_rcp(d.x); r.y = fast_rcp(d.y);
    return x * r;
}
#define XB_TMO      128
#define XB_XCNT(j)  (256  + 64 * (j))
#define XB_XSUB(j)  (1280 + 64 * (j))
#define XB_XGEN(j)  (2304 + 64 * (j))
#define XB_TOP      3328
#define XB_TOPGEN   3392
#define XCD_BAR_WORDS 3456
#define XB_SPIN_CAP (1u << 18)
__device__ __forceinline__ unsigned xb_ld(unsigned* p)              { return __hip_atomic_load(p, __ATOMIC_RELAXED, __HIP_MEMORY_SCOPE_AGENT); }
__device__ __forceinline__ unsigned xb_add(unsigned* p, unsigned v) { return __hip_atomic_fetch_add(p, v, __ATOMIC_RELAXED, __HIP_MEMORY_SCOPE_AGENT); }
__device__ __forceinline__ unsigned xb_xcc_id() { return (unsigned)__builtin_amdgcn_s_getreg((3 << 11) | 20) & 0xFu; }
#define XB_SPIN(cond, bar) do { unsigned _sp = 0; while (cond) { __builtin_amdgcn_s_sleep(1); \
    if ((++_sp & 255u) == 0u) { if (xb_ld(&(bar)[XB_TMO])) break; if (_sp > XB_SPIN_CAP) { atomicAdd(&(bar)[XB_TMO], 1u); break; } } } } while (0)
struct XcdBarrier { unsigned* bar; unsigned x; volatile LAS unsigned* st; };
__device__ __forceinline__ XcdBarrier xcd_barrier_post(unsigned* bar, volatile LAS unsigned* st) {
    XcdBarrier b; b.bar = bar; b.x = xb_xcc_id(); b.st = st;
    if (threadIdx.x == 0) (void)xb_add(&bar[XB_XCNT(b.x)], 1u);
    return b;
}
__device__ __forceinline__ void xcd_barrier_complete(unsigned* bar, unsigned x, unsigned& nloc, unsigned& nx) {
    const unsigned G = gridDim.x * gridDim.y * gridDim.z;
    unsigned sum, cnt, mine, sp = 0u;
    for (;;) {
        sum = 0u; cnt = 0u; mine = 0u;
#pragma unroll
        for (unsigned j = 0; j < 16; ++j) { const unsigned c = xb_ld(&bar[XB_XCNT(j)]); sum += c; cnt += (c > 0u) ? 1u : 0u; mine = (j == x) ? c : mine; }
        if (sum == G) break;
        __builtin_amdgcn_s_sleep(1);
        if ((++sp & 255u) == 0u) { if (xb_ld(&bar[XB_TMO])) break; if (sp > XB_SPIN_CAP) { atomicAdd(&bar[XB_TMO], 1u); break; } }
    }
    nloc = mine > 0u ? mine : 1u; nx = cnt > 0u ? cnt : 1u;
}
__device__ __forceinline__ void xcd_barrier(const XcdBarrier& b) {
    asm volatile("s_waitcnt vmcnt(0)" ::: "memory");
    __syncthreads();
    if (threadIdx.x == 0) {
        unsigned* bar = b.bar;
        __builtin_amdgcn_s_waitcnt(0);
        unsigned nloc = b.st[0], nx = b.st[1];
        if (nloc == 0u) { xcd_barrier_complete(bar, b.x, nloc, nx); b.st[0] = nloc; b.st[1] = nx; }
        const unsigned old = xb_add(&bar[XB_XSUB(b.x)], 1u);
        const unsigned gen = old / nloc;
        if (old + 1u == (gen + 1u) * nloc) {
            __builtin_amdgcn_fence(__ATOMIC_RELEASE, "agent");
            asm volatile("s_waitcnt vmcnt(0)" ::: "memory");
            const unsigned og = xb_add(&bar[XB_TOP], 1u);
            const unsigned tg = og / nx;
            if (og + 1u == (tg + 1u) * nx) xb_add(&bar[XB_TOPGEN], 1u);
            else XB_SPIN(xb_ld(&bar[XB_TOPGEN]) == tg, bar);
            __builtin_amdgcn_fence(__ATOMIC_ACQUIRE, "agent");
            xb_add(&bar[XB_XGEN(b.x)], 1u);
            asm volatile("s_waitcnt vmcnt(0)" ::: "memory");
        } else {
            XB_SPIN(xb_ld(&bar[XB_XGEN(b.x)]) == gen, bar);
            __builtin_amdgcn_fence(__ATOMIC_ACQUIRE, "agent");
            asm volatile("s_waitcnt vmcnt(0)" ::: "memory");
        }
    }
    __syncthreads();
}

__device__ __forceinline__ void xcd_barrier_arrive_only(const XcdBarrier& b) {
    unsigned* bar = b.bar;
    const unsigned nloc = b.st[0], nx = b.st[1];
    const unsigned old = xb_add(&bar[XB_XSUB(b.x)], 1u);
    const unsigned gen = old / nloc;
    if (old + 1u == (gen + 1u) * nloc) {
        __builtin_amdgcn_fence(__ATOMIC_RELEASE, "agent");
        asm volatile("s_waitcnt vmcnt(0)" ::: "memory");
        const unsigned og = xb_add(&bar[XB_TOP], 1u);
        const unsigned tg = og / nx;
        if (og + 1u == (tg + 1u) * nx) xb_add(&bar[XB_TOPGEN], 1u);
        else XB_SPIN(xb_ld(&bar[XB_TOPGEN]) == tg, bar);
        __builtin_amdgcn_fence(__ATOMIC_ACQUIRE, "agent");
        xb_add(&bar[XB_XGEN(b.x)], 1u);
        asm volatile("s_waitcnt vmcnt(0)" ::: "memory");
    }
}

namespace pg8 {
constexpr int BM = 256, BK = 64, HALF = 128, HTB = HALF * BK * 2, STAGE_BYTES = 8 * HTB, NXCD = 8, WGM = 8;
__host__ __device__ __forceinline__ int lds_byte(int r, int c) { const int st = (r >> 4) * 2 + (c >> 5), rr = r & 15, cc = c & 31, ob = rr * 64 + cc * 2; return st * 1024 + (ob ^ (((ob >> 9) & 1) << 5)); }
__host__ __device__ __forceinline__ void stage_rc(int b, int& R, int& C) { const int st = b / 1024, sb = b % 1024, swz = sb ^ (((sb >> 9) & 1) << 5); R = (st >> 1) * 16 + swz / 64; C = (st & 1) * 32 + (swz % 64) / 2; }
__host__ __device__ __forceinline__ int perm32(int rho) { const int n = rho >> 4, i = rho & 15; return 8 * (i >> 2) + 4 * n + (i & 3); }
struct Unit { int pm, pn; };
struct Gemm { const bf16_t* A; const bf16_t* Bt; int M, N, K; };
struct StaticOrder {
    int nM, nN, nwg, G, c;
    __host__ __device__ void init(int M, int N, int G_, int c_) { nM = M / BM; nN = N / BM; nwg = nM * nN; G = G_; c = c_; }
    __host__ __device__ bool next(int i, Unit& u) const {
        const long L = (long)i * G + c; if (L >= nwg) return false;
        int wgid = (int)L; { const int q = nwg / NXCD, r = nwg % NXCD, xcd = wgid % NXCD, off = wgid / NXCD; wgid = (xcd < r ? xcd * (q + 1) : r * (q + 1) + (xcd - r) * q) + off; }
        const int nig = WGM * nN, gid = wgid / nig, fm = gid * WGM, gsz = (nM - fm) < WGM ? (nM - fm) : WGM;
        u.pm = fm + ((wgid % nig) % gsz); u.pn = (wgid % nig) / gsz; return true;
    }
    __device__ __forceinline__ void a_ready(const Unit&) const {}
    __device__ __forceinline__ void done(const Unit&) const {}
};

struct Order2 {
    int rd, c;
    __device__ bool next(int i, Unit& u) const {
        if (i != 0) return false;
        if (rd == 0) { const int x = c & 7, j = c >> 3; u.pm = x * 4 + (j >> 3); u.pn = j & 7; return c < 256; }
        u.pm = 32 + (c >> 3); u.pn = c & 7; return c < 32;
    }
    __device__ __forceinline__ void a_ready(const Unit&) const {}
    __device__ __forceinline__ void done(const Unit&) const {}
};
struct OrderG2 {
    int c; XcdBarrier bar; LAS unsigned* wcnt;
    __device__ bool next(int i, Unit& u) const {
        if (i == 0) { const int x = c & 7, j = c >> 3; u.pm = x * 4 + (j >> 3); u.pn = j & 7; return true; }
        if (i == 1 && c < 32) { u.pm = 32 + (c >> 3); u.pn = c & 7; return true; }
        return false;
    }
    __device__ __forceinline__ void a_ready(const Unit&) const {}
    __device__ __forceinline__ void done(const Unit& u) const {
        if (c < 32 && u.pm < 32) {
            asm volatile("s_waitcnt vmcnt(0)" ::: "memory");
            if ((threadIdx.x & 63) == 0) {
                const unsigned o = __hip_atomic_fetch_add((unsigned*)wcnt, 1u, __ATOMIC_RELAXED, __HIP_MEMORY_SCOPE_WORKGROUP);
                if (o == 7u) xcd_barrier_arrive_only(bar);
            }
        }
    }
};
struct EpiProj {
    static constexpr bool PERM = true, AFTER_DRAIN = false;
    bf16_t* sec; float* vss;
    __device__ __forceinline__ void operator()(const f32x4 (&acc)[2][2][4][2], const Unit& u, int wr, int wc, int fr, int fq) const {
        const int s = u.pn >> 2, ct = u.pn & 3;
        bf16_t* base = sec + (size_t)s * SEC_STRIDE;
        const int row0 = u.pm * BM + wr * 64 + fr, col0 = ct * 256 + wc * 32 + 8 * fq;
        const bool is_gelu = (s == 2 || s == 3);
        const float ka = is_gelu ? -2.30220819f : -1.44269504f, kb = is_gelu ? -0.10294324f : 0.0f;
#pragma unroll
        for (int ai = 0; ai < 2; ++ai)
#pragma unroll
            for (int m = 0; m < 4; ++m) {
                const int row = row0 + ai * HALF + m * 16;
                bf16_t* rowp = base + (size_t)row * 1024 + col0;
                float ss = 0.f;
#pragma unroll
                for (int bj = 0; bj < 2; ++bj) {
                    f32x4 v0 = acc[ai][bj][m][0], v1 = acc[ai][bj][m][1];
                    if (s != 0) {
#pragma unroll
                        for (int j = 0; j < 4; j += 2) { const f32x2 a = act_gate2((f32x2){v0[j], v0[j + 1]}, ka, kb), b = act_gate2((f32x2){v1[j], v1[j + 1]}, ka, kb); v0[j] = a.x; v0[j + 1] = a.y; v1[j] = b.x; v1[j + 1] = b.y; }
                    }
                    ss += (v0[0] * v0[0] + v0[1] * v0[1]) + (v0[2] * v0[2] + v0[3] * v0[3]) + (v1[0] * v1[0] + v1[1] * v1[1]) + (v1[2] * v1[2] + v1[3] * v1[3]);
                    u32x4 w; w.x = cvt_pk_bf16(v0[0], v0[1]); w.y = cvt_pk_bf16(v0[2], v0[3]); w.z = cvt_pk_bf16(v1[0], v1[1]); w.w = cvt_pk_bf16(v1[2], v1[3]);
                    *(u32x4*)(rowp + bj * HALF) = w;
                }
                if (s == 3) {
                    ss += __shfl_xor(ss, 16); ss += __shfl_xor(ss, 32);
                    if (fq == 0) vss[(size_t)row * 16 + ct * 4 + wc] = ss;
                }
            }
    }
};
struct EpiOut {
    static constexpr bool PERM = true, AFTER_DRAIN = false;
    bf16_t* O; float* oss;
    __device__ __forceinline__ void operator()(const f32x4 (&acc)[2][2][4][2], const Unit& u, int wr, int wc, int fr, int fq) const {
        const int row0 = u.pm * BM + wr * 64 + fr, col0 = u.pn * BM + wc * 32 + 8 * fq;
#pragma unroll
        for (int ai = 0; ai < 2; ++ai)
#pragma unroll
            for (int m = 0; m < 4; ++m) {
                const int row = row0 + ai * HALF + m * 16;
                bf16_t* rowp = O + (size_t)row * 2048 + col0;
                float ss = 0.f;
#pragma unroll
                for (int bj = 0; bj < 2; ++bj) {
                    const f32x4 v0 = acc[ai][bj][m][0], v1 = acc[ai][bj][m][1];
                    ss += (v0[0] * v0[0] + v0[1] * v0[1]) + (v0[2] * v0[2] + v0[3] * v0[3]) + (v1[0] * v1[0] + v1[1] * v1[1]) + (v1[2] * v1[2] + v1[3] * v1[3]);
                    u32x4 w; w.x = cvt_pk_bf16(v0[0], v0[1]); w.y = cvt_pk_bf16(v0[2], v0[3]); w.z = cvt_pk_bf16(v1[0], v1[1]); w.w = cvt_pk_bf16(v1[2], v1[3]);
                    *(u32x4*)(rowp + bj * HALF) = w;
                }
                ss += __shfl_xor(ss, 16); ss += __shfl_xor(ss, 32);
                if (fq == 0) oss[(size_t)row * 32 + u.pn * 4 + wc] = ss;
            }
    }
};

template <class Epi, class Sched>
__device__ __forceinline__ void gemm_phase(LAS unsigned char* lds, const Gemm g, const Sched& S, const Epi& E) {
    const int tid = threadIdx.x, wid = __builtin_amdgcn_readfirstlane(tid >> 6), lane = tid & 63, wr = wid >> 2, wc = wid & 3, fr = lane & 15, fq = lane >> 4;
    const int K = g.K, nt = K / BK;
    unsigned voffA[2], voffB[2];
#pragma unroll
    for (int i = 0; i < 2; ++i) { int R, C; stage_rc(tid * 16 + i * 8192, R, C); const int Rb = Epi::PERM ? ((R & ~31) + perm32(R & 31)) : R;
        voffA[i] = (unsigned)(R * K + C) * 2u; voffB[i] = (unsigned)(Rb * K + C) * 2u; }
    const size_t kstep = (size_t)(BK * 2);
    const size_t hstep = (size_t)HALF * K * 2;
    const size_t tstep = 2 * hstep;
    const unsigned ldsw = (unsigned)wid * 1024u;
    const int aoff = lds_byte(wr * 64 + fr, fq * 8), boff = lds_byte(wc * 32 + fr, fq * 8);
#define PG8_SA(b, h) (((b) * 2 + (h)) * HTB)
#define PG8_SB(b, h) ((4 + (b) * 2 + (h)) * HTB)
#define PG8_STAGE(bufoff, gbase, voff) do { _Pragma("unroll") for (int _i = 0; _i < 2; ++_i) \
        __builtin_amdgcn_global_load_lds((const unsigned*)((const char*)(gbase) + (voff)[_i]), (LAS unsigned*)(lds + (bufoff) + ldsw + _i * 8192), 16, 0, 0); } while (0)
#define PG8_LDA(dst, b, h) do { _Pragma("unroll") for (int m = 0; m < 4; ++m) _Pragma("unroll") for (int k = 0; k < 2; ++k) dst[m][k] = *(const LAS bf16x8*)(lds + PG8_SA(b, h) + aoff + m * 2048 + k * 1024); } while (0)
#define PG8_LDB(dst, b, h) do { _Pragma("unroll") for (int n = 0; n < 2; ++n) _Pragma("unroll") for (int k = 0; k < 2; ++k) dst[n][k] = *(const LAS bf16x8*)(lds + PG8_SB(b, h) + boff + n * 2048 + k * 1024); } while (0)
#define PG8_MMA(ai, bj, At, Bt) do { __builtin_amdgcn_s_setprio(1); _Pragma("unroll") for (int m = 0; m < 4; ++m) _Pragma("unroll") for (int n = 0; n < 2; ++n) _Pragma("unroll") for (int k = 0; k < 2; ++k) \
        acc[ai][bj][m][n] = __builtin_amdgcn_mfma_f32_16x16x32_bf16(Bt[n][k], At[m][k], acc[ai][bj][m][n], 0, 0, 0); __builtin_amdgcn_s_setprio(0); } while (0)
#define PG8_WAIT_V(n) asm volatile("s_waitcnt vmcnt(" #n ")" ::: "memory")
#define PG8_WAIT_L(n) asm volatile("s_waitcnt lgkmcnt(" #n ")" ::: "memory")
#define PG8_BAR __builtin_amdgcn_s_barrier()
#define PG8_SCHED __builtin_amdgcn_sched_barrier(0)
    Unit cur, nxt; int ui = 0;
    if (!S.next(0, cur)) return;
    f32x4 acc[2][2][4][2];
#pragma unroll
    for (int a = 0; a < 2; ++a)
#pragma unroll
        for (int b = 0; b < 2; ++b)
#pragma unroll
            for (int m = 0; m < 4; ++m)
#pragma unroll
                for (int n = 0; n < 2; ++n) acc[a][b][m][n] = (f32x4){0.f, 0.f, 0.f, 0.f};
    bf16x8 At[4][2], B0[2][2], B1[2][2];
    const char* cA = (const char*)g.A + (size_t)cur.pm * tstep; const char* cB = (const char*)g.Bt + (size_t)cur.pn * tstep;
    S.a_ready(cur);
    PG8_STAGE(PG8_SB(0, 0), cB, voffB); PG8_STAGE(PG8_SA(0, 0), cA, voffA); PG8_STAGE(PG8_SB(0, 1), cB + hstep, voffB); PG8_STAGE(PG8_SA(0, 1), cA + hstep, voffA);
    if (wr == 1) PG8_BAR;
    PG8_WAIT_V(4); PG8_BAR;
    PG8_STAGE(PG8_SB(1, 0), cB + kstep, voffB); PG8_STAGE(PG8_SA(1, 0), cA + kstep, voffA); PG8_STAGE(PG8_SB(1, 1), cB + hstep + kstep, voffB);
    PG8_WAIT_V(6); PG8_BAR;
    for (;;) {
        const bool has_next = S.next(ui + 1, nxt);
        const char* nA = has_next ? (const char*)g.A + (size_t)nxt.pm * tstep : cA; const char* nB = has_next ? (const char*)g.Bt + (size_t)nxt.pn * tstep : cB;
        for (int t = 0; t < nt; t += 2) {
            const bool last = (t == nt - 2);
            const char* a1 = cA + (size_t)(t + 1) * kstep;
            const char* a2 = last ? nA : cA + (size_t)(t + 2) * kstep; const char* b2 = last ? nB : cB + (size_t)(t + 2) * kstep;
            const char* a3 = a2 + kstep; const char* b3 = b2 + kstep;
            if (last && has_next) S.a_ready(nxt);
            PG8_LDB(B0, 0, 0); PG8_SCHED; PG8_LDA(At, 0, 0); PG8_STAGE(PG8_SA(1, 1), a1 + hstep, voffA);
            PG8_WAIT_L(8); PG8_BAR; PG8_WAIT_L(0); PG8_MMA(0, 0, At, B0); PG8_BAR; PG8_SCHED;
            PG8_LDB(B1, 0, 1); PG8_STAGE(PG8_SB(0, 0), b2, voffB);
            PG8_BAR; PG8_WAIT_L(0); PG8_MMA(0, 1, At, B1); PG8_BAR;
            PG8_LDA(At, 0, 1); PG8_STAGE(PG8_SA(0, 0), a2, voffA);
            PG8_BAR; PG8_WAIT_L(0); PG8_MMA(1, 0, At, B0); PG8_BAR; PG8_SCHED;
            PG8_STAGE(PG8_SB(0, 1), b2 + hstep, voffB);
            PG8_WAIT_V(6); PG8_BAR; PG8_MMA(1, 1, At, B1); PG8_BAR;
            PG8_LDB(B0, 1, 0); PG8_SCHED; PG8_LDA(At, 1, 0); PG8_STAGE(PG8_SA(0, 1), a2 + hstep, voffA);
            PG8_WAIT_L(8); PG8_BAR; PG8_WAIT_L(0); PG8_MMA(0, 0, At, B0); PG8_BAR; PG8_SCHED;
            PG8_LDB(B1, 1, 1); PG8_STAGE(PG8_SB(1, 0), b3, voffB);
            PG8_BAR; PG8_WAIT_L(0); PG8_MMA(0, 1, At, B1); PG8_BAR;
            PG8_LDA(At, 1, 1); PG8_STAGE(PG8_SA(1, 0), a3, voffA);
            PG8_BAR; PG8_WAIT_L(0); PG8_MMA(1, 0, At, B0); PG8_BAR; PG8_SCHED;
            PG8_STAGE(PG8_SB(1, 1), b3 + hstep, voffB);
            PG8_WAIT_V(6); PG8_BAR; PG8_MMA(1, 1, At, B1); PG8_BAR;
        }
        if constexpr (!Epi::AFTER_DRAIN) { E(acc, cur, wr, wc, fr, fq); S.done(cur); }
        if (!has_next) break;
#pragma unroll
        for (int a = 0; a < 2; ++a)
#pragma unroll
            for (int b = 0; b < 2; ++b)
#pragma unroll
                for (int m = 0; m < 4; ++m)
#pragma unroll
                    for (int n = 0; n < 2; ++n) acc[a][b][m][n] = (f32x4){0.f, 0.f, 0.f, 0.f};
        cur = nxt; cA = nA; cB = nB; ++ui;
    }
    PG8_WAIT_V(0);
    if (wr == 0) PG8_BAR;
    PG8_BAR;
#undef PG8_SA
#undef PG8_SB
#undef PG8_STAGE
#undef PG8_LDA
#undef PG8_LDB
#undef PG8_MMA
#undef PG8_WAIT_V
#undef PG8_WAIT_L
#undef PG8_BAR
#undef PG8_SCHED
}
}

constexpr int CVT_NT1 = 32 * 160, CVT_NT2 = 32 * 64;
__device__ __forceinline__ void convert_weights(const Params& p, int t_lo, int t_hi, int gw, int nw) {
    const int lane = threadIdx.x & 63, kg = lane & 7, nq = lane >> 3;
    unsigned char* ws = p.ws;
    for (int wt = t_lo + gw; wt < t_hi; wt += 2 * nw) {
        f32x4 v[2][8]; bf16_t* dstp[2]; bool ok[2];
#pragma unroll
        for (int u = 0; u < 2; ++u) {
            const int w_ = wt + u * nw; ok[u] = w_ < t_hi;
            const int w2 = ok[u] ? w_ : wt;
            const float* src; bf16_t* dst; int ldn, kt, nt;
            if (w2 < CVT_NT1) { src = p.in[6]; dst = (bf16_t*)(ws + WS_BT1); ldn = PW; kt = w2 / 160; nt = w2 % 160; }
            else { const int t2 = w2 - CVT_NT1; src = p.in[17]; dst = (bf16_t*)(ws + WS_BT2); ldn = 2048; kt = t2 / 64; nt = t2 % 64; }
            const int k0 = kt * 64 + 8 * kg, n = nt * 32 + 4 * nq;
            const float* sp = src + (size_t)k0 * ldn + n;
#pragma unroll
            for (int r = 0; r < 8; ++r) v[u][r] = __builtin_nontemporal_load((const f32x4*)(sp + (size_t)r * ldn));
            dstp[u] = dst + (size_t)n * 2048 + k0;
        }
#pragma unroll
        for (int u = 0; u < 2; ++u) {
            if (ok[u]) {
#pragma unroll
                for (int j = 0; j < 4; ++j) {
                    u32x4 w; w.x = cvt_pk_bf16(v[u][0][j], v[u][1][j]); w.y = cvt_pk_bf16(v[u][2][j], v[u][3][j]); w.z = cvt_pk_bf16(v[u][4][j], v[u][5][j]); w.w = cvt_pk_bf16(v[u][6][j], v[u][7][j]);
                    *(u32x4*)(dstp[u] + (size_t)j * 2048) = w;
                }
            }
        }
    }
}

__device__ __forceinline__ void convert_small_weights(const Params& p, int t0, int nt) {
    unsigned char* ws = p.ws;
    {
        const int total = 2 * 8 * 16 * 128;
        for (int idx = t0; idx < total; idx += nt) {
            const int j = idx & 127, k8 = (idx >> 7) & 15, h = (idx >> 11) & 7, which = idx >> 14;
            const float* w = (which ? p.in[11] : p.in[9]) + (size_t)h * 128 * 128;
            float f[8];
#pragma unroll
            for (int i = 0; i < 8; ++i) f[i] = w[(k8 * 8 + i) * 128 + j];
            u32x4 o; o.x = cvt_pk_bf16(f[0], f[1]); o.y = cvt_pk_bf16(f[2], f[3]); o.z = cvt_pk_bf16(f[4], f[5]); o.w = cvt_pk_bf16(f[6], f[7]);
            bf16_t* dst = (bf16_t*)(ws + (which ? WS_WIT : WS_WRT));
            *(u32x4*)(dst + ((size_t)h * 128 + j) * 128 + k8 * 8) = o;
        }
    }
    {
        const int total = 2 * 8 * 128 * 16;
        for (int idx = t0; idx < total; idx += nt) {
            const int s8 = (idx & 15) * 8, t = (idx >> 4) & 127, h = (idx >> 11) & 7, which = idx >> 14;
            const float* w = p.in[15] + (size_t)h * 128 * 128;
            float f[8];
#pragma unroll
            for (int i = 0; i < 8; ++i) {
                if (!which) f[i] = (s8 + i <= t) ? w[t * 128 + s8 + i] : 0.f;
                else f[i] = ((s8 >> 3) == (t >> 3) && i <= (t & 7)) ? w[(t & 7) * 128 + i] : 0.f;
            }
            u32x4 o; o.x = cvt_pk_bf16(f[0], f[1]); o.y = cvt_pk_bf16(f[2], f[3]); o.z = cvt_pk_bf16(f[4], f[5]); o.w = cvt_pk_bf16(f[6], f[7]);
            bf16_t* dst = (bf16_t*)(ws + (which ? WS_WMS : WS_WMP));
            *(u32x4*)(dst + ((size_t)h * 128 + t) * 128 + s8) = o;
        }
    }
}

__device__ __forceinline__ void p0_prep(const Params& p, LAS unsigned char* lds) {
    const int tid = threadIdx.x, lane = tid & 63, wid = tid >> 6;
    unsigned char* ws = p.ws;
    convert_weights(p, 0, (gridDim.x == 256) ? CVT_NT1 : CVT_NT1 + CVT_NT2, blockIdx.x * 8 + wid, gridDim.x * 8);
    if (gridDim.x != 256) convert_small_weights(p, blockIdx.x * 512 + tid, gridDim.x * 512);
    {
        bf16_t* zb = (bf16_t*)(ws + WS_ZB);
        const float* gpre = p.in[4];
        f32x4 gg[8];
#pragma unroll
        for (int i = 0; i < 8; ++i) gg[i] = *(const f32x4*)(gpre + (lane + 64 * i) * 4);
        for (int row = blockIdx.x * 8 + wid; row < MT; row += gridDim.x * 8) {
            const float* xr = row < MP ? p.in[0] + (size_t)row * 2048 : p.in[1] + (size_t)(row - MP) * 2048;
            f32x4 v[8]; float ss = 0.f;
#pragma unroll
            for (int i = 0; i < 8; ++i) { v[i] = __builtin_nontemporal_load((const f32x4*)(xr + (lane + 64 * i) * 4)); ss += (v[i][0] * v[i][0] + v[i][1] * v[i][1]) + (v[i][2] * v[i][2] + v[i][3] * v[i][3]); }
#pragma unroll
            for (int o = 32; o >= 1; o >>= 1) ss += __shfl_xor(ss, o);
            const float rs = rsqrtf(ss * (1.0f / 2048.0f) + EPS);
#pragma unroll
            for (int i = 0; i < 8; ++i) {
                u32x2 w; w.x = cvt_pk_bf16(v[i][0] * rs * gg[i][0], v[i][1] * rs * gg[i][1]); w.y = cvt_pk_bf16(v[i][2] * rs * gg[i][2], v[i][3] * rs * gg[i][3]);
                *(u32x2*)(zb + (size_t)row * 2048 + (lane + 64 * i) * 4) = w;
            }
        }
    }
}

constexpr int XCB_LD = 136, XCF_LD = 132, XCF_OFF = 128 * XCB_LD * 2, HIN_OFF = XCF_OFF + 128 * XCF_LD * 4, CW_OFF = HIN_OFF + 512;
__device__ __forceinline__ void unpack8(const u32x4 w, float (&f)[8]) { f[0] = bf_lo(w.x); f[1] = bf_hi(w.x); f[2] = bf_lo(w.y); f[3] = bf_hi(w.y); f[4] = bf_lo(w.z); f[5] = bf_hi(w.z); f[6] = bf_lo(w.w); f[7] = bf_hi(w.w); }
struct LruIn { u32x4 xw[7]; };
template <int MODE>
__device__ __forceinline__ void lru_load(const Params& p, int g, int h, LruIn& R) {
    int tid_ = threadIdx.x; asm volatile("" : "+v"(tid_));
    const int tid = tid_, lane = tid & 63, wid = __builtin_amdgcn_readfirstlane(tid >> 6), fr = lane & 15, fq = lane >> 4;
    unsigned char* ws = p.ws;
    const bf16_t* XR = (const bf16_t*)(ws + WS_SEC);
    const bf16_t* SGR = XR + SEC_STRIDE;
    const int row0 = g * 128, ch0 = h * 128;
    constexpr bool samp = (MODE == 1), fused = (MODE == 2);
    const int c = g & 15, ns0 = (g - NGRP_P) * 16;
    const int rg = tid >> 4, c8 = (tid & 15) * 8, chl = 16 * wid + fr;
#pragma unroll
    for (int k = 0; k < 7; ++k) {
        const int rr = 4 * rg + k - 3;
        if (samp && k < 3 && (rg & 1) == 0) {
            const float* st = p.in[2] + ((size_t)(ns0 + (rg >> 1)) * 3 + k) * 1024 + ch0 + c8;
            const f32x4 a = *(const f32x4*)st, b = *(const f32x4*)(st + 4);
            R.xw[k].x = cvt_pk_bf16(a[0], a[1]); R.xw[k].y = cvt_pk_bf16(a[2], a[3]); R.xw[k].z = cvt_pk_bf16(b[0], b[1]); R.xw[k].w = cvt_pk_bf16(b[2], b[3]);
        } else if (samp || c * 128 + rr >= 0) {
            R.xw[k] = __builtin_nontemporal_load((const u32x4*)(XR + (size_t)(row0 + rr) * 1024 + ch0 + c8));
        } else R.xw[k] = (u32x4){0u, 0u, 0u, 0u};
    }
}
template <int MODE>
__device__ __forceinline__ void lru_unit(const Params& p, LAS unsigned char* lds, int g, int h, LruIn& IN, bool pf_next, int gn, int hn, LruIn& NX, const float c_r, const float c_i, const float spl) {
    int tid_ = threadIdx.x; asm volatile("" : "+v"(tid_));
    const int tid = tid_, lane = tid & 63, wid = __builtin_amdgcn_readfirstlane(tid >> 6), fr = lane & 15, fq = lane >> 4;
    unsigned char* ws = p.ws;
    const bf16_t* XR = (const bf16_t*)(ws + WS_SEC);
    const bf16_t* SGR = XR + SEC_STRIDE;
    bf16_t* A2 = (bf16_t*)(ws + WS_A2);
    float* AGG = (float*)(ws + WS_AGG);
    unsigned* AB = (unsigned*)(ws + WS_AB);
    LAS bf16_t* XCB = (LAS bf16_t*)lds;
    LAS float* XCF = (LAS float*)(lds + XCF_OFF);
    const int row0 = g * 128, ch0 = h * 128;
    constexpr bool samp = (MODE == 1), fused = (MODE == 2);
    const int c = g & 15, nseq = g >> 4;
    const int ns0 = (g - NGRP_P) * 16;
    const int rg = tid >> 4, c8 = (tid & 15) * 8;
    const int lrow0 = 16 * (rg & 7) + 4 * (rg >> 3);
    const int chl = 16 * wid + fr, ch = ch0 + chl;
    bf16x8 br[4], bi[4];
    {
        const bf16_t* WRT = (const bf16_t*)(ws + WS_WRT) + ((size_t)h * 128 + chl) * 128 + 8 * fq;
        const bf16_t* WIT = (const bf16_t*)(ws + WS_WIT) + ((size_t)h * 128 + chl) * 128 + 8 * fq;
#pragma unroll
        for (int ks = 0; ks < 4; ++ks) { br[ks] = *(const bf16x8*)(WRT + 32 * ks); bi[ks] = *(const bf16x8*)(WIT + 32 * ks); }
    }
    float h0v[4];
    u32x4 sgrk[4];
    if (samp || fused) {
#pragma unroll
        for (int i = 0; i < 4; ++i) sgrk[i] = __builtin_nontemporal_load((const u32x4*)(SGR + (size_t)(row0 + 4 * rg + i) * 1024 + ch0 + c8));
    }
    if (samp) {
#pragma unroll
        for (int k = 0; k < 4; ++k) h0v[k] = p.in[3][(size_t)(ns0 + 4 * fq + k) * 1024 + ch];
    }
    {
        {
            const bool tail = samp ? ((rg & 1) != 0) : (c == 15 && rg == 31);
            if (tail) {
                float* dst = samp ? p.out + O_CONVS + ((size_t)(ns0 + (rg >> 1)) * 3) * 1024 + ch0 + c8 : p.out + O_CONVP + ((size_t)nseq * 3) * 1024 + ch0 + c8;
#pragma unroll
                for (int k = 4; k < 7; ++k) { float f[8]; unpack8(IN.xw[k], f); *(f32x4*)(dst + (k - 4) * 1024) = (f32x4){f[0], f[1], f[2], f[3]}; *(f32x4*)(dst + (k - 4) * 1024 + 4) = (f32x4){f[4], f[5], f[6], f[7]}; }
            }
        }
        float acc[4][8];
        {
            const LAS float* CWL = (const LAS float*)(lds + CW_OFF);
            const f32x4 a = *(const LAS f32x4*)(CWL + c8), b = *(const LAS f32x4*)(CWL + c8 + 4);
#pragma unroll
            for (int i = 0; i < 4; ++i) { acc[i][0] = a[0]; acc[i][1] = a[1]; acc[i][2] = a[2]; acc[i][3] = a[3]; acc[i][4] = b[0]; acc[i][5] = b[1]; acc[i][6] = b[2]; acc[i][7] = b[3]; }
        }
#pragma unroll
        for (int kw = 0; kw < 4; ++kw) {
            const LAS float* CWL = (const LAS float*)(lds + CW_OFF) + 128 * (kw + 1);
            const f32x4 a = *(const LAS f32x4*)(CWL + c8), b = *(const LAS f32x4*)(CWL + c8 + 4);
            const float cw[8] = {a[0], a[1], a[2], a[3], b[0], b[1], b[2], b[3]};
#pragma unroll
            for (int i = 0; i < 4; ++i) { float f[8]; unpack8(IN.xw[i + kw], f);
#pragma unroll
                for (int e = 0; e < 8; ++e) acc[i][e] += cw[e] * f[e]; }
        }
#pragma unroll
        for (int i = 0; i < 4; ++i) {
            const int r = lrow0 + i;
            u32x4 w; w.x = cvt_pk_bf16(acc[i][0], acc[i][1]); w.y = cvt_pk_bf16(acc[i][2], acc[i][3]); w.z = cvt_pk_bf16(acc[i][4], acc[i][5]); w.w = cvt_pk_bf16(acc[i][6], acc[i][7]);
            *(LAS u32x4*)(XCB + r * XCB_LD + c8) = w;
        }
    }
    __syncthreads();
    f32x4 ar[8], ai[8];
#pragma unroll
    for (int m = 0; m < 8; ++m) { ar[m] = (f32x4){0.f, 0.f, 0.f, 0.f}; ai[m] = (f32x4){0.f, 0.f, 0.f, 0.f}; }
#pragma unroll
    for (int m = 0; m < 8; ++m)
#pragma unroll
        for (int ks = 0; ks < 4; ++ks) {
            const bf16x8 a = *(const LAS bf16x8*)(XCB + (16 * m + fr) * XCB_LD + 32 * ks + 8 * fq);
            ar[m] = __builtin_amdgcn_mfma_f32_16x16x32_bf16(a, br[ks], ar[m], 0, 0, 0);
            ai[m] = __builtin_amdgcn_mfma_f32_16x16x32_bf16(a, bi[ks], ai[m], 0, 0, 0);
        }
    constexpr float L2E = 1.44269504f;
    float A = 1.f, B = 0.f;
#pragma unroll
    for (int m = 0; m < 8; ++m) {
#pragma unroll
        for (int jp = 0; jp < 4; jp += 2) {
            const f32x2 zr = (f32x2){ar[m][jp], ar[m][jp + 1]} * (-L2E) + c_r, zi = (f32x2){ai[m][jp], ai[m][jp + 1]} * (-L2E) + c_i;
            f32x2 er, ei; er.x = fast_exp2(zr.x); er.y = fast_exp2(zr.y); ei.x = fast_exp2(zi.x); ei.y = fast_exp2(zi.y);
            const f32x2 dr = er + 1.0f, di = ei + 1.0f;
            f32x2 rr, ii; rr.x = fast_rcp(dr.x); rr.y = fast_rcp(dr.y); ii.x = fast_rcp(di.x); ii.y = fast_rcp(di.y);
            f32x2 la = rr * spl;
            f32x2 a; a.x = fast_exp2(la.x); a.y = fast_exp2(la.y);
            const f32x2 om = 1.0f - a * a;
            f32x2 mult; mult.x = __builtin_amdgcn_sqrtf(om.x); mult.y = __builtin_amdgcn_sqrtf(om.y);
            const f32x2 xc = (f32x2){__uint_as_float((unsigned)XCB[(16 * m + 4 * fq + jp) * XCB_LD + chl] << 16), __uint_as_float((unsigned)XCB[(16 * m + 4 * fq + jp + 1) * XCB_LD + chl] << 16)};
            if (!samp && m == 0 && jp == 0) { if (c == 0 && fq == 0) { a.x = 0.f; mult.x = 1.f; la.x = -INFINITY; } }
            f32x2 b = mult * ii * xc;
            if (samp && jp == 0 && (m & 1) == 0) { b.x += a.x * h0v[m >> 1]; a.x = 0.f; }
            B = a.x * B + b.x; A = a.x * A;
            if (MODE == 0) AB[(size_t)(row0 + 32 * fq + 4 * m + jp) * 1024 + ch] = cvt_pk_bf16(la.x, b.x);
            else { ar[m][jp] = A; ai[m][jp] = B; }
            B = a.y * B + b.y; A = a.y * A;
            if (MODE == 0) AB[(size_t)(row0 + 32 * fq + 4 * m + jp + 1) * 1024 + ch] = cvt_pk_bf16(la.y, b.y);
            else { ar[m][jp + 1] = A; ai[m][jp + 1] = B; }
        }
    }
    if (pf_next) lru_load<MODE>(p, gn, hn, NX);
    if (MODE == 0) {
        float Ai = A, Bi = B;
        { const float sa = __shfl_up(Ai, 16), sb = __shfl_up(Bi, 16); if (fq >= 1) { Bi = Ai * sb + Bi; Ai = sa * Ai; } }
        { const float sa = __shfl_up(Ai, 32), sb = __shfl_up(Bi, 32); if (fq >= 2) { Bi = Ai * sb + Bi; Ai = sa * Ai; } }
        if (fq == 3) { float* a = AGG + ((size_t)(g * 8 + h)) * 256 + chl; a[0] = Ai; a[128] = Bi; }
        __syncthreads();
        return;
    }
    if (fused) {
        float Ai = A, Bi = B;
        { const float sa = __shfl_up(Ai, 16), sb = __shfl_up(Bi, 16); if (fq >= 1) { Bi = Ai * sb + Bi; Ai = sa * Ai; } }
        { const float sa = __shfl_up(Ai, 32), sb = __shfl_up(Bi, 32); if (fq >= 2) { Bi = Ai * sb + Bi; Ai = sa * Ai; } }
        float ea = __shfl_up(Ai, 16), eb = __shfl_up(Bi, 16); if (fq == 0) { ea = 1.f; eb = 0.f; }
        unsigned long long* GR = (unsigned long long*)(ws + WS_AGG);
        if (fq == 3) __hip_atomic_store(GR + ((size_t)(g * 8 + h)) * 128 + chl, ((unsigned long long)__float_as_uint(Bi) << 32) | (unsigned long long)(__float_as_uint(Ai) | 0x80000000u), __ATOMIC_RELAXED, __HIP_MEMORY_SCOPE_AGENT);
        if (tid < 128 && c > 0) {
            const unsigned long long* gp = GR + ((size_t)(nseq * 16) * 8 + h) * 128 + tid;
            unsigned long long gv[15]; unsigned polls = 0;
            for (;;) {
                bool ok = true;
#pragma unroll
                for (int cc = 0; cc < 15; ++cc) { const int ci = cc < c ? cc : 0; gv[cc] = __hip_atomic_load(gp + (size_t)ci * 1024, __ATOMIC_RELAXED, __HIP_MEMORY_SCOPE_AGENT); }
#pragma unroll
                for (int cc = 0; cc < 15; ++cc) ok = ok && ((int)(unsigned)gv[cc] < 0);
                if (__all(ok) || ++polls > (1u << 18)) break;
                __builtin_amdgcn_s_sleep(1);
            }
            float Hc = 0.f;
#pragma unroll
            for (int cc = 0; cc < 15; ++cc) Hc = (cc < c) ? __uint_as_float((unsigned)(gv[cc] >> 32)) + __uint_as_float((unsigned)gv[cc] & 0x7fffffffu) * Hc : Hc;
            ((LAS float*)(lds + HIN_OFF))[tid] = Hc;
        }
        __syncthreads();
        const float Hin = c > 0 ? ((LAS float*)(lds + HIN_OFF))[chl] : 0.f;
        const float hs = eb + ea * Hin;
#pragma unroll
        for (int m = 0; m < 8; ++m)
#pragma unroll
            for (int j = 0; j < 4; ++j) ai[m][j] = ai[m][j] + ar[m][j] * hs;
    }
#pragma unroll
    for (int m = 0; m < 8; ++m)
#pragma unroll
        for (int j = 0; j < 4; ++j) XCF[(16 * m + 4 * fq + j) * XCF_LD + chl] = ai[m][j];
    __syncthreads();
    {
#pragma unroll
        for (int i = 0; i < 4; ++i) {
            const int r = 4 * rg + i, lr = lrow0 + i;
            const f32x4 h0 = *(const LAS f32x4*)(XCF + lr * XCF_LD + c8), h1 = *(const LAS f32x4*)(XCF + lr * XCF_LD + c8 + 4);
            const u32x4 gw = sgrk[i];
            u32x4 w; w.x = cvt_pk_bf16(h0[0] * bf_lo(gw.x), h0[1] * bf_hi(gw.x)); w.y = cvt_pk_bf16(h0[2] * bf_lo(gw.y), h0[3] * bf_hi(gw.y));
            w.z = cvt_pk_bf16(h1[0] * bf_lo(gw.z), h1[1] * bf_hi(gw.z)); w.w = cvt_pk_bf16(h1[2] * bf_lo(gw.w), h1[3] * bf_hi(gw.w));
            *(u32x4*)(A2 + (size_t)(row0 + r) * 2048 + ch0 + c8) = w;
            if (samp) { if (i == 3 && (rg & 1) != 0) { float* dst = p.out + O_HS + (size_t)(ns0 + (rg >> 1)) * 1024 + ch0 + c8; *(f32x4*)dst = h0; *(f32x4*)(dst + 4) = h1; } }
            else { if (i == 3 && c == 15 && rg == 31) { float* dst = p.out + O_HP + (size_t)nseq * 1024 + ch0 + c8; *(f32x4*)dst = h0; *(f32x4*)(dst + 4) = h1; } }
        }
    }
    __syncthreads();
}

template <int MODE>
__device__ __forceinline__ void lru_run(const Params& p, LAS unsigned char* lds, int first, int count, int stride, int gofs) {
    LruIn La, Lb;
    const int u0 = first, u1 = first + stride, u2 = first + 2 * stride;
    lru_load<MODE>(p, gofs + (u0 >> 3), u0 & 7, La);
    if (threadIdx.x < 160) {
        const int k = threadIdx.x >> 5, c4 = (threadIdx.x & 31) * 4;
        const float* src = (k == 0 ? p.in[8] : p.in[7] + (k - 1) * 1024) + (u0 & 7) * 128 + c4;
        *(LAS f32x4*)((LAS float*)(lds + CW_OFF) + 128 * k + c4) = *(const f32x4*)src;
    }
    __syncthreads();
    constexpr float L2E = 1.44269504f;
    const int chn = (u0 & 7) * 128 + 16 * (int)(threadIdx.x >> 6) + (int)(threadIdx.x & 15);
    const float c_r = -L2E * p.in[10][chn], c_i = -L2E * p.in[12][chn];
    float spl;
    { const float nl = -p.in[13][chn]; spl = -8.0f * L2E * (fmaxf(nl, 0.f) + log1pf(__expf(-fabsf(nl)))); }
    lru_unit<MODE>(p, lds, gofs + (u0 >> 3), u0 & 7, La, count > 1, gofs + (u1 >> 3), u1 & 7, Lb, c_r, c_i, spl);
    if (count > 1) {
        lru_unit<MODE>(p, lds, gofs + (u1 >> 3), u1 & 7, Lb, count > 2, gofs + (u2 >> 3), u2 & 7, La, c_r, c_i, spl);
        if (count > 2) lru_unit<MODE>(p, lds, gofs + (u2 >> 3), u2 & 7, La, false, 0, 0, Lb, c_r, c_i, spl);
    }
}

__device__ __forceinline__ void lru_pass2_unit(const Params& p, LAS unsigned char* lds, int g, int h) {
    int tid_ = threadIdx.x; asm volatile("" : "+v"(tid_));
    const int tid = tid_, q = __builtin_amdgcn_readfirstlane(tid >> 6), cp = (tid & 63) * 2;
    unsigned char* ws = p.ws;
    const bf16_t* SGR = (const bf16_t*)(ws + WS_SEC) + SEC_STRIDE;
    bf16_t* A2 = (bf16_t*)(ws + WS_A2);
    const float* AGG = (const float*)(ws + WS_AGG);
    const unsigned* AB = (const unsigned*)(ws + WS_AB);
    LAS float* HIN = (LAS float*)lds;
    LAS float* TOT = (LAS float*)(lds + 512);
    const int row0 = g * 128, ch0 = h * 128, c = g & 15, nseq = g >> 4;
    u32x2 ab[16]; unsigned sg[16];
#pragma unroll
    for (int r = 0; r < 16; ++r) {
        ab[r] = __builtin_nontemporal_load((const u32x2*)(AB + (size_t)(row0 + 16 * q + r) * 1024 + ch0 + cp));
        sg[r] = __builtin_nontemporal_load((const unsigned*)(SGR + (size_t)(row0 + 16 * q + r) * 1024 + ch0 + cp));
    }
    if (tid < 128) {
        const float* a = AGG + ((size_t)(nseq * 16) * 8 + h) * 256 + tid;
        float H = 0.f;
#pragma unroll
        for (int c0 = 0; c0 < 15; c0 += 5) {
            float Pv[5], Bv[5];
#pragma unroll
            for (int cc = 0; cc < 5; ++cc) { const int ci = (c0 + cc) < c ? (c0 + cc) : 0; Pv[cc] = a[(size_t)ci * 2048]; Bv[cc] = a[(size_t)ci * 2048 + 128]; }
#pragma unroll
            for (int cc = 0; cc < 5; ++cc) H = ((c0 + cc) < c) ? Bv[cc] + Pv[cc] * H : H;
        }
        HIN[tid] = H;
    }
    float av0[16], av1[16];
    float A0 = 1.f, B0 = 0.f, A1 = 1.f, B1 = 0.f;
#pragma unroll
    for (int r = 0; r < 16; ++r) {
        av0[r] = fast_exp2(bf_lo(ab[r].x)); av1[r] = fast_exp2(bf_lo(ab[r].y));
        B0 = av0[r] * B0 + bf_hi(ab[r].x); A0 *= av0[r];
        B1 = av1[r] * B1 + bf_hi(ab[r].y); A1 *= av1[r];
    }
    TOT[(q * 2 + 0) * 128 + cp] = A0; TOT[(q * 2 + 0) * 128 + cp + 1] = A1;
    TOT[(q * 2 + 1) * 128 + cp] = B0; TOT[(q * 2 + 1) * 128 + cp + 1] = B1;
    __syncthreads();
    float H0 = HIN[cp], H1 = HIN[cp + 1];
    for (int qq = 0; qq < q; ++qq) {
        H0 = TOT[(qq * 2 + 1) * 128 + cp] + TOT[(qq * 2 + 0) * 128 + cp] * H0;
        H1 = TOT[(qq * 2 + 1) * 128 + cp + 1] + TOT[(qq * 2 + 0) * 128 + cp + 1] * H1;
    }
#pragma unroll
    for (int r = 0; r < 16; ++r) {
        H0 = av0[r] * H0 + bf_hi(ab[r].x); H1 = av1[r] * H1 + bf_hi(ab[r].y);
        *(unsigned*)(A2 + (size_t)(row0 + 16 * q + r) * 2048 + ch0 + cp) = cvt_pk_bf16(H0 * bf_lo(sg[r]), H1 * bf_hi(sg[r]));
    }
    if (c == 15 && q == 7) { *(f32x2*)(p.out + O_HP + (size_t)nseq * 1024 + ch0 + cp) = (f32x2){H0, H1}; }
    __syncthreads();
}


struct SguRegs { bf16x8 wfrag[4]; u32x4 gu[4], sg[4]; float bias; u32x4 gv[4]; float q[4]; f32x4 g0, g1; };
template <bool EARLY, bool LATE>
__device__ __forceinline__ void sgu_stage1a(const Params& p, int g, int h, SguRegs& R) {
    int tid_ = threadIdx.x; asm volatile("" : "+v"(tid_));
    const int tid = tid_, lane = tid & 63, wid = __builtin_amdgcn_readfirstlane(tid >> 6), fr = lane & 15, fq = lane >> 4;
    unsigned char* ws = p.ws;
    const bf16_t* GU = (const bf16_t*)(ws + WS_SEC) + 2 * SEC_STRIDE;
    const bf16_t* GV = GU + SEC_STRIDE;
    const bf16_t* SGS = GV + SEC_STRIDE;
    const float* VSS = (const float*)(ws + WS_VSS);
    const int row0 = g * 128, d0 = h * 128;
    const bool samp = g >= NGRP_P;
    const int d8 = (tid & 15) * 8, sb = tid >> 4;
    if (EARLY) {
#pragma unroll
        for (int it = 0; it < 4; ++it) R.gv[it] = __builtin_nontemporal_load((const u32x4*)(GV + (size_t)(row0 + sb + 32 * it) * 1024 + d0 + d8));
#pragma unroll
        for (int it = 0; it < 4; ++it) R.q[it] = VSS[(size_t)(row0 + sb + 32 * it) * 16 + (tid & 15)];
        R.g0 = *(const f32x4*)(p.in[14] + d0 + d8); R.g1 = *(const f32x4*)(p.in[14] + d0 + d8 + 4);
    }
    if (LATE) {
        const bf16_t* WM = (const bf16_t*)(ws + (samp ? WS_WMS : WS_WMP)) + ((size_t)h * 128 + 16 * wid + fr) * 128 + 8 * fq;
#pragma unroll
        for (int ks = 0; ks < 4; ++ks) R.wfrag[ks] = *(const bf16x8*)(WM + 32 * ks);
        const int t = 16 * wid + fr, row = row0 + t;
#pragma unroll
        for (int k = 0; k < 4; ++k) { const int col = d0 + 32 * k + 8 * fq; R.gu[k] = __builtin_nontemporal_load((const u32x4*)(GU + (size_t)row * 1024 + col)); R.sg[k] = __builtin_nontemporal_load((const u32x4*)(SGS + (size_t)row * 1024 + col)); }
        R.bias = p.in[16][h * 128 + (samp ? (t & 7) : t)];
    }
}
__device__ __forceinline__ void sgu_stage1b(const Params& p, LAS unsigned char* lds, int g, int h, int vt_off, SguRegs& R) {
    int tid_ = threadIdx.x; asm volatile("" : "+v"(tid_));
    const int tid = tid_;
    LAS bf16_t* VT = (LAS bf16_t*)(lds + vt_off);
    const int row0 = g * 128, d0 = h * 128;
    const bool samp = g >= NGRP_P;
    const int d8 = (tid & 15) * 8, sb = tid >> 4;
    float rsv[4];
#pragma unroll
    for (int it = 0; it < 4; ++it) {
        float q = R.q[it];
        q += __shfl_xor(q, 1); q += __shfl_xor(q, 2); q += __shfl_xor(q, 4); q += __shfl_xor(q, 8);
        rsv[it] = rsqrtf(q * (1.0f / 1024.0f) + EPS);
    }
    const float gg[8] = {R.g0[0], R.g0[1], R.g0[2], R.g0[3], R.g1[0], R.g1[1], R.g1[2], R.g1[3]};
#pragma unroll
    for (int it = 0; it < 4; ++it) {
        const int s = sb + 32 * it;
        const float rs = rsv[it];
        float f[8]; unpack8(R.gv[it], f);
#pragma unroll
        for (int i = 0; i < 8; ++i) f[i] = f[i] * rs * gg[i];
        if (samp) {
            float* dst = p.out + O_V + (size_t)(row0 - MP + s) * 1024 + d0 + d8;
            *(f32x4*)dst = (f32x4){f[0], f[1], f[2], f[3]}; *(f32x4*)(dst + 4) = (f32x4){f[4], f[5], f[6], f[7]};
        }
        u32x4 w; w.x = cvt_pk_bf16(f[0], f[1]); w.y = cvt_pk_bf16(f[2], f[3]); w.z = cvt_pk_bf16(f[4], f[5]); w.w = cvt_pk_bf16(f[6], f[7]);
        *(LAS u32x4*)((LAS unsigned char*)VT + 256 * s + 16 * ((tid & 15) ^ (((s & 3) << 2) | ((s >> 2) & 3)))) = w;
    }
}
__device__ __forceinline__ void sgu_stage2(const Params& p, LAS unsigned char* lds, int g, int h, int vt_off, const SguRegs& R) {
    int tid_ = threadIdx.x; asm volatile("" : "+v"(tid_));
    const int tid = tid_, lane = tid & 63, wid = __builtin_amdgcn_readfirstlane(tid >> 6), fr = lane & 15, fq = lane >> 4;
    bf16_t* A2 = (bf16_t*)(p.ws + WS_A2);
    LAS bf16_t* VT = (LAS bf16_t*)(lds + vt_off);
    const int row = g * 128 + 16 * wid + fr, d0 = h * 128;
    f32x4 acc[8];
#pragma unroll
    for (int n = 0; n < 8; ++n) acc[n] = (f32x4){0.f, 0.f, 0.f, 0.f};
    const int ksmax = wid >> 1;
    int frv = fr; asm volatile("" : "+v"(frv));
#pragma unroll
    for (int ks = 0; ks < 4; ++ks) {
        if (ks <= ksmax) {
#pragma unroll
            for (int n = 0; n < 8; ++n) {
                bf16x8 vfrag;
#pragma unroll
                for (int t2 = 0; t2 < 2; ++t2) {
                    const int row = 32 * ks + 8 * fq + 4 * t2 + (frv >> 2);
                    const int ch = (4 * (n >> 1) + (frv & 3)) ^ (((row & 3) << 2) | ((row >> 2) & 3));
                    const s16x4 h = __builtin_amdgcn_ds_read_tr16_b64_v4i16((LAS s16x4*)((LAS unsigned char*)VT + 256 * row + 16 * ch + 8 * (n & 1)));
                    vfrag[4 * t2 + 0] = h[0]; vfrag[4 * t2 + 1] = h[1]; vfrag[4 * t2 + 2] = h[2]; vfrag[4 * t2 + 3] = h[3];
                }
                acc[n] = __builtin_amdgcn_mfma_f32_16x16x32_bf16(vfrag, R.wfrag[ks], acc[n], 0, 0, 0);
            }
        }
    }
    const float bias = R.bias;
#pragma unroll
    for (int k = 0; k < 4; ++k) {
        const int col = d0 + 32 * k + 8 * fq;
        const f32x4 a0 = acc[2 * k], a1 = acc[2 * k + 1];
        u32x4 w;
        w.x = cvt_pk_bf16((a0[0] + bias) * bf_lo(R.gu[k].x) * bf_lo(R.sg[k].x), (a0[1] + bias) * bf_hi(R.gu[k].x) * bf_hi(R.sg[k].x));
        w.y = cvt_pk_bf16((a0[2] + bias) * bf_lo(R.gu[k].y) * bf_lo(R.sg[k].y), (a0[3] + bias) * bf_hi(R.gu[k].y) * bf_hi(R.sg[k].y));
        w.z = cvt_pk_bf16((a1[0] + bias) * bf_lo(R.gu[k].z) * bf_lo(R.sg[k].z), (a1[1] + bias) * bf_hi(R.gu[k].z) * bf_hi(R.sg[k].z));
        w.w = cvt_pk_bf16((a1[2] + bias) * bf_lo(R.gu[k].w) * bf_lo(R.sg[k].w), (a1[3] + bias) * bf_hi(R.gu[k].w) * bf_hi(R.sg[k].w));
        *(u32x4*)(A2 + (size_t)row * 2048 + 1024 + col) = w;
    }
}
__device__ __forceinline__ void sgu_run(const Params& p, LAS unsigned char* lds, int first, int count, int stride) {
    SguRegs Ra, Rb;
    if (count <= 0) return;
    sgu_stage1a<true, true>(p, first >> 3, first & 7, Ra);
#pragma unroll 1
    for (int k = 0; k < count; k += 2) {
        const int u0 = first + k * stride, u1 = u0 + stride;
        const bool has1 = (k + 1) < count, has2 = (k + 2) < count;
        if (has1) sgu_stage1a<true, true>(p, u1 >> 3, u1 & 7, Rb);
        sgu_stage1b(p, lds, u0 >> 3, u0 & 7, 0, Ra);
        __syncthreads();
        sgu_stage2(p, lds, u0 >> 3, u0 & 7, 0, Ra);
        if (!has1) break;
        if (has2) { const int u2 = u1 + stride; sgu_stage1a<true, true>(p, u2 >> 3, u2 & 7, Ra); }
        sgu_stage1b(p, lds, u1 >> 3, u1 & 7, 34816, Rb);
        __syncthreads();
        sgu_stage2(p, lds, u1 >> 3, u1 & 7, 34816, Rb);
    }
}


__device__ __forceinline__ void p5_final(const Params& p, int row_lo, int row_hi, int worker, int nworkers) {
    const int tid = threadIdx.x, lane = tid & 63, wid = tid >> 6;
    const bf16_t* OB = (const bf16_t*)(p.ws + WS_OUTB);
    const float* OSS = (const float*)(p.ws + WS_OSS);
    const float* gpost = p.in[5];
    f32x4 gA[4], gB[4];
#pragma unroll
    for (int i = 0; i < 4; ++i) { const int col = (lane + 64 * i) * 8; gA[i] = *(const f32x4*)(gpost + col); gB[i] = *(const f32x4*)(gpost + col + 4); }
    for (int row = row_lo + worker * 8 + wid; row < row_hi; row += nworkers * 8) {
        const float* xr = row < MP ? p.in[0] + (size_t)row * 2048 : p.in[1] + (size_t)(row - MP) * 2048;
        float* yr = p.out + O_Y + (size_t)row * 2048;
        float ss = (lane < 32) ? OSS[(size_t)row * 32 + lane] : 0.f;
        u32x4 o[4]; f32x4 x0[4], x1[4];
#pragma unroll
        for (int i = 0; i < 4; ++i) {
            const int col = (lane + 64 * i) * 8;
            o[i] = __builtin_nontemporal_load((const u32x4*)(OB + (size_t)row * 2048 + col));
            x0[i] = __builtin_nontemporal_load((const f32x4*)(xr + col)); x1[i] = __builtin_nontemporal_load((const f32x4*)(xr + col + 4));
        }
#pragma unroll
        for (int of = 32; of >= 1; of >>= 1) ss += __shfl_xor(ss, of);
        const float rs = rsqrtf(ss * (1.0f / 2048.0f) + EPS);
#pragma unroll
        for (int i = 0; i < 4; ++i) {
            const int col = (lane + 64 * i) * 8;
            const f32x4 g0 = gA[i], g1 = gB[i];
            f32x4 y0, y1;
            y0[0] = x0[i][0] + bf_lo(o[i].x) * rs * g0[0]; y0[1] = x0[i][1] + bf_hi(o[i].x) * rs * g0[1]; y0[2] = x0[i][2] + bf_lo(o[i].y) * rs * g0[2]; y0[3] = x0[i][3] + bf_hi(o[i].y) * rs * g0[3];
            y1[0] = x1[i][0] + bf_lo(o[i].z) * rs * g1[0]; y1[1] = x1[i][1] + bf_hi(o[i].z) * rs * g1[1]; y1[2] = x1[i][2] + bf_lo(o[i].w) * rs * g1[2]; y1[3] = x1[i][3] + bf_hi(o[i].w) * rs * g1[3];
            __builtin_nontemporal_store(y0, (f32x4*)(yr + col)); __builtin_nontemporal_store(y1, (f32x4*)(yr + col + 4));
        }
    }
}

constexpr int LDS_BYTES = pg8::STAGE_BYTES + 16;
__global__ void __launch_bounds__(512, 2) hymba_fwd(Params p) {
    extern __shared__ __attribute__((aligned(16))) unsigned char shm[];
    LAS unsigned char* lds = (LAS unsigned char*)shm;
    const int lo = p.ph_lo, hi = p.ph_hi;
    XcdBarrier bar; bar.bar = nullptr; bar.x = 0; bar.st = nullptr;
    if (hi - lo > 1) {
        volatile LAS unsigned* st = (volatile LAS unsigned*)(lds + pg8::STAGE_BYTES);
        if (threadIdx.x == 0) { st[0] = 0u; st[1] = 0u; st[2] = 0u; }
        __syncthreads();
        bar = xcd_barrier_post((unsigned*)(p.ws + WS_BAR), st);
    }
#define IN(k) (lo <= (k) && (k) < hi)
#define SEAM(k) do { if (IN(k) && IN((k) + 1)) xcd_barrier(bar); } while (0)
    if (IN(0)) { p0_prep(p, lds); }
    SEAM(0);
    if (IN(1)) {
        pg8::Gemm g{(const bf16_t*)(p.ws + WS_ZB), (const bf16_t*)(p.ws + WS_BT1), MT, PW, 2048};
        pg8::StaticOrder S; S.init(MT, PW, (int)gridDim.x, (int)blockIdx.x);
        pg8::EpiProj E{(bf16_t*)(p.ws + WS_SEC), (float*)(p.ws + WS_VSS)};
        pg8::gemm_phase<pg8::EpiProj, pg8::StaticOrder>(lds, g, S, E);
        if (gridDim.x == 256 && blockIdx.x >= 208) {
            convert_small_weights(p, ((int)blockIdx.x - 208) * 512 + (int)threadIdx.x, 48 * 512);
            convert_weights(p, CVT_NT1, CVT_NT1 + CVT_NT2, ((int)blockIdx.x - 208) * 8 + (int)(threadIdx.x >> 6), 48 * 8);
        }
    }
    SEAM(1);
    if (IN(2)) {
        if (gridDim.x == 256) {
            const int grp = blockIdx.x >> 6, bl = blockIdx.x & 63;
            const int nL = grp == 0 ? 2 : grp == 1 ? 1 : grp == 2 ? 3 : 2, L0 = grp == 0 ? 0 : grp == 1 ? 128 : grp == 2 ? 192 : 384;
            const int nS = grp == 0 ? 3 : grp == 1 ? 4 : 1, S0 = grp == 0 ? 0 : grp == 1 ? 192 : grp == 2 ? 448 : 512;
            lru_run<LRU_FUSED ? 2 : 0>(p, lds, L0 + bl, nL, 64, 0);
            sgu_run(p, lds, S0 + bl, nS, 64);
            if (grp == 3) { __syncthreads(); lru_run<1>(p, lds, bl, 1, 0, NGRP_P); }
        } else {
            const int nu = NGRP_P * 8 + NGRP * 8 + (NGRP - NGRP_P) * 8;
            int nsgu = 0;
            for (int u = blockIdx.x; u < nu; u += gridDim.x) {
                if (u < NGRP_P * 8) { __syncthreads(); lru_run<LRU_FUSED ? 2 : 0>(p, lds, u, 1, 0, 0); }
                else if (u < NGRP_P * 8 + NGRP * 8) { const int v = u - NGRP_P * 8; __syncthreads(); sgu_run(p, lds, v, 1, 0); }
                else { const int v = u - NGRP_P * 8 - NGRP * 8; __syncthreads(); lru_run<1>(p, lds, v, 1, 0, NGRP_P); }
            }
        }
    }
    SEAM(2);
#if !LRU_FUSED
    if (IN(3)) {
        for (int u = blockIdx.x; u < NGRP_P * 8; u += gridDim.x) lru_pass2_unit(p, lds, u >> 3, u & 7);
    }
    SEAM(3);
#endif
#if N_LAUNCHES == 1
    if (IN(4) && IN(5)) {
        pg8::Gemm g{(const bf16_t*)(p.ws + WS_A2), (const bf16_t*)(p.ws + WS_BT2), MT, 2048, 2048};
        pg8::OrderG2 S{(int)blockIdx.x, bar, (LAS unsigned*)(lds + pg8::STAGE_BYTES + 8)};
        pg8::EpiOut E{(bf16_t*)(p.ws + WS_OUTB), (float*)(p.ws + WS_OSS)};
        pg8::gemm_phase<pg8::EpiOut, pg8::OrderG2>(lds, g, S, E);
        if (blockIdx.x >= 32) { xcd_barrier(bar); p5_final(p, 0, MP, (int)blockIdx.x - 32, (int)gridDim.x - 32); }
        xcd_barrier(bar);
    }
#else
#pragma unroll 1
    for (int rd = 0; rd < 2; ++rd) {
        if (IN(4 + rd)) {
            if (rd == 0 || blockIdx.x < 32 || gridDim.x <= 32) {
                pg8::Gemm g{(const bf16_t*)(p.ws + WS_A2), (const bf16_t*)(p.ws + WS_BT2), MT, 2048, 2048};
                pg8::Order2 S{rd, (int)blockIdx.x};
                pg8::EpiOut E{(bf16_t*)(p.ws + WS_OUTB), (float*)(p.ws + WS_OSS)};
                pg8::gemm_phase<pg8::EpiOut, pg8::Order2>(lds, g, S, E);
            }
            if (rd == 1 && blockIdx.x >= 32) p5_final(p, 0, MP, (int)blockIdx.x - 32, (int)gridDim.x - 32);
        }
        SEAM(4 + rd);
    }
#endif
    if (IN(6)) { p5_final(p, MP, MT, (int)blockIdx.x, (int)gridDim.x); }
#undef IN
#undef SEAM
}

extern "C" void kernel_launch(void* const* d_in, const int* in_sizes, int n_in, void* d_out, int out_size, void* d_ws, size_t ws_size, hipStream_t stream) {
    static int grid = 0;
    if (grid == 0) {
        int dev = 0, cus = 0, per_cu = 0;
        if (n_in != 18 || ws_size < WS_END) { fprintf(stderr, "kernel_launch: unexpected problem (n_in %d, ws %zu < %zu)\n", n_in, ws_size, (size_t)WS_END); grid = -1; return; }
        hipGetDevice(&dev);
        hipDeviceGetAttribute(&cus, hipDeviceAttributeMultiprocessorCount, dev);
        if (hipFuncSetAttribute((const void*)hymba_fwd, hipFuncAttributeMaxDynamicSharedMemorySize, LDS_BYTES) != hipSuccess) { fprintf(stderr, "kernel_launch: hipFuncSetAttribute failed\n"); grid = -1; return; }
        hipOccupancyMaxActiveBlocksPerMultiprocessor(&per_cu, (const void*)hymba_fwd, 512, LDS_BYTES);
        if (per_cu < 1) { fprintf(stderr, "kernel_launch: occupancy query says %d blocks per CU\n", per_cu); per_cu = 1; }
        (void)hipGetLastError();
        grid = cus;
    }
    if (grid < 0) return;
    Params p{};
    for (int i = 0; i < 18; ++i) p.in[i] = (const float*)d_in[i];
    const size_t ws_shift = (ws_size - WS_END) & ~(size_t)((2u << 20) - 1);
    p.out = (float*)d_out; p.ws = (unsigned char*)d_ws + ws_shift;
#if N_LAUNCHES == 1
    p.ph_lo = 0; p.ph_hi = 7;
    if (hipMemsetAsync((char*)p.ws + WS_BAR, 0, WS_END - WS_BAR, stream) != hipSuccess) { fprintf(stderr, "kernel_launch: memset of the barrier words / scan granules failed\n"); return; }
    hipLaunchKernelGGL(hymba_fwd, dim3(grid), dim3(512), LDS_BYTES, stream, p);
#else
#ifndef PROBE_SEQ
#define PROBE_SEQ {0, 1, 2, 3, 4, 5, 6}
#endif
    const int seq[] = PROBE_SEQ;
    for (int k : seq) {
        p.ph_lo = k; p.ph_hi = k + 1;
        hipLaunchKernelGGL(hymba_fwd, dim3(grid), dim3(512), LDS_BYTES, stream, p);
    }
#endif
}
```

```cpp
#include <hip/hip_runtime.h>
#include <cstdio>

#ifndef N_LAUNCHES
#define N_LAUNCHES 1
#endif

#ifndef LRU_FUSED
#define LRU_FUSED 1
#endif
#define LAS __attribute__((address_space(3)))
typedef unsigned short bf16_t;
typedef short bf16x8 __attribute__((ext_vector_type(8)));
typedef float f32x4 __attribute__((ext_vector_type(4)));
typedef float f32x2 __attribute__((ext_vector_type(2)));
typedef unsigned u32x4 __attribute__((ext_vector_type(4)));
typedef unsigned u32x2 __attribute__((ext_vector_type(2)));

constexpr int D_MODEL = 2048, MP = 8192  , MS = 1024  , MT = MP + MS, PW = 5120, LW = 1024, SW = 1024;
constexpr int NGRP = MT / 128  , NGRP_P = MP / 128  ;
constexpr float EPS = 1e-6f;
constexpr size_t O_Y = 0, O_CONVP = (size_t)MT * D_MODEL, O_HP = O_CONVP + 4 * 3 * 1024, O_CONVS = O_HP + 4 * 1024, O_HS = O_CONVS + 128 * 3 * 1024, O_V = O_HS + 128 * 1024;
constexpr size_t WS_ZB = 0;
constexpr size_t WS_BT1 = WS_ZB + (size_t)MT * 2048 * 2;
constexpr size_t WS_BT2 = WS_BT1 + (size_t)PW * 2048 * 2;
constexpr size_t WS_SEC = WS_BT2 + (size_t)2048 * 2048 * 2;
constexpr size_t SEC_STRIDE = (size_t)MT * 1024;
constexpr size_t WS_A2 = WS_ZB;
constexpr size_t WS_OUTB = WS_SEC;
constexpr size_t WS_VSS = WS_SEC + 5 * SEC_STRIDE * 2;
constexpr size_t WS_OSS = WS_VSS + (size_t)MT * 16 * 4;
constexpr size_t WS_WRT = WS_OSS + (size_t)MT * 32 * 4;
constexpr size_t WS_WIT = WS_WRT + (size_t)8 * 128 * 128 * 2;
constexpr size_t WS_WMP = WS_WIT + (size_t)8 * 128 * 128 * 2;
constexpr size_t WS_WMS = WS_WMP + (size_t)8 * 128 * 128 * 2;
constexpr size_t WS_AB = WS_WMS + (size_t)8 * 128 * 128 * 2;
constexpr size_t WS_BAR = WS_AB + (size_t)MP * 1024 * 4;
constexpr size_t WS_AGG = WS_BAR + 16384;
constexpr size_t WS_END = WS_AGG + (size_t)64 * 8 * 128 * 8;

struct Params {
    const float* in[18];
    float* out;
    unsigned char* ws;
    int ph_lo, ph_hi;
};

__device__ __forceinline__ unsigned cvt_pk_bf16(float lo, float hi) { unsigned r; asm volatile("v_cvt_pk_bf16_f32 %0, %1, %2" : "=v"(r) : "v"(lo), "v"(hi)); return r; }
__device__ __forceinline__ float bf_lo(unsigned w) { return __uint_as_float(w << 16); }
__device__ __forceinline__ float bf_hi(unsigned w) { return __uint_as_float(w & 0xffff0000u); }
__device__ __forceinline__ float fast_rcp(float x) { return __builtin_amdgcn_rcpf(x); }
__device__ __forceinline__ float fast_exp2(float x) { return __builtin_amdgcn_exp2f(x); }
__device__ __forceinline__ float sigmoidf_(float x) { return fast_rcp(1.0f + fast_exp2(-1.44269504f * x)); }
__device__ __forceinline__ float act_gate(float x, float ka, float kb) { return x * fast_rcp(1.0f + fast_exp2(x * (ka + kb * x * x))); }


__device__ __forceinline__ f32x2 act_gate2(f32x2 x, float ka, float kb) {
    const f32x2 y = x * (x * x * kb + ka);
    f32x2 e; e.x = fast_exp2(y.x); e.y = fast_exp2(y.y);
    const f32x2 d = e + 1.0f;
    f32x2 r; r.x = fast_rcp(d.x); r.y = fast_rcp(d.y);
    return x * r;
}
#define XB_TMO      128
#define XB_XCNT(j)  (256  + 64 * (j))
#define XB_XSUB(j)  (1280 + 64 * (j))
#define XB_XGEN(j)  (2304 + 64 * (j))
#define XB_TOP      3328
#define XB_TOPGEN   3392
#define XCD_BAR_WORDS 3456
#define XB_SPIN_CAP (1u << 18)
__device__ __forceinline__ unsigned xb_ld(unsigned* p)              { return __hip_atomic_load(p, __ATOMIC_RELAXED, __HIP_MEMORY_SCOPE_AGENT); }
__device__ __forceinline__ unsigned xb_add(unsigned* p, unsigned v) { return __hip_atomic_fetch_add(p, v, __ATOMIC_RELAXED, __HIP_MEMORY_SCOPE_AGENT); }
__device__ __forceinline__ unsigned xb_xcc_id() { return (unsigned)__builtin_amdgcn_s_getreg((3 << 11) | 20) & 0xFu; }
#define XB_SPIN(cond, bar) do { unsigned _sp = 0; while (cond) { __builtin_amdgcn_s_sleep(1); \
    if ((++_sp & 255u) == 0u) { if (xb_ld(&(bar)[XB_TMO])) break; if (_sp > XB_SPIN_CAP) { atomicAdd(&(bar)[XB_TMO], 1u); break; } } } } while (0)
struct XcdBarrier { unsigned* bar; unsigned x; volatile LAS unsigned* st; };
__device__ __forceinline__ XcdBarrier xcd_barrier_post(unsigned* bar, volatile LAS unsigned* st) {
    XcdBarrier b; b.bar = bar; b.x = xb_xcc_id(); b.st = st;
    if (threadIdx.x == 0) (void)xb_add(&bar[XB_XCNT(b.x)], 1u);
    return b;
}
__device__ __forceinline__ void xcd_barrier_complete(unsigned* bar, unsigned x, unsigned& nloc, unsigned& nx) {
    const unsigned G = gridDim.x * gridDim.y * gridDim.z;
    unsigned sum, cnt, mine, sp = 0u;
    for (;;) {
        sum = 0u; cnt = 0u; mine = 0u;
#pragma unroll
        for (unsigned j = 0; j < 16; ++j) { const unsigned c = xb_ld(&bar[XB_XCNT(j)]); sum += c; cnt += (c > 0u) ? 1u : 0u; mine = (j == x) ? c : mine; }
        if (sum == G) break;
        __builtin_amdgcn_s_sleep(1);
        if ((++sp & 255u) == 0u) { if (xb_ld(&bar[XB_TMO])) break; if (sp > XB_SPIN_CAP) { atomicAdd(&bar[XB_TMO], 1u); break; } }
    }
    nloc = mine > 0u ? mine : 1u; nx = cnt > 0u ? cnt : 1u;
}
__device__ __forceinline__ void xcd_barrier(const XcdBarrier& b) {
    asm volatile("s_waitcnt vmcnt(0)" ::: "memory");
    __syncthreads();
    if (threadIdx.x == 0) {
        unsigned* bar = b.bar;
        __builtin_amdgcn_s_waitcnt(0);
        unsigned nloc = b.st[0], nx = b.st[1];
        if (nloc == 0u) { xcd_barrier_complete(bar, b.x, nloc, nx); b.st[0] = nloc; b.st[1] = nx; }
        const unsigned old = xb_add(&bar[XB_XSUB(b.x)], 1u);
        const unsigned gen = old / nloc;
        if (old + 1u == (gen + 1u) * nloc) {
            __builtin_amdgcn_fence(__ATOMIC_RELEASE, "agent");
            asm volatile("s_waitcnt vmcnt(0)" ::: "memory");
            const unsigned og = xb_add(&bar[XB_TOP], 1u);
            const unsigned tg = og / nx;
            if (og + 1u == (tg + 1u) * nx) xb_add(&bar[XB_TOPGEN], 1u);
            else XB_SPIN(xb_ld(&bar[XB_TOPGEN]) == tg, bar);
            __builtin_amdgcn_fence(__ATOMIC_ACQUIRE, "agent");
            xb_add(&bar[XB_XGEN(b.x)], 1u);
            asm volatile("s_waitcnt vmcnt(0)" ::: "memory");
        } else {
            XB_SPIN(xb_ld(&bar[XB_XGEN(b.x)]) == gen, bar);
            __builtin_amdgcn_fence(__ATOMIC_ACQUIRE, "agent");
            asm volatile("s_waitcnt vmcnt(0)" ::: "memory");
        }
    }
    __syncthreads();
}

__device__ __forceinline__ void xcd_barrier_arrive_only(const XcdBarrier& b) {
    unsigned* bar = b.bar;
    const unsigned nloc = b.st[0], nx = b.st[1];
    const unsigned old = xb_add(&bar[XB_XSUB(b.x)], 1u);
    const unsigned gen = old / nloc;
    if (old + 1u == (gen + 1u) * nloc) {
        __builtin_amdgcn_fence(__ATOMIC_RELEASE, "agent");
        asm volatile("s_waitcnt vmcnt(0)" ::: "memory");
        const unsigned og = xb_add(&bar[XB_TOP], 1u);
        const unsigned tg = og / nx;
        if (og + 1u == (tg + 1u) * nx) xb_add(&bar[XB_TOPGEN], 1u);
        else XB_SPIN(xb_ld(&bar[XB_TOPGEN]) == tg, bar);
        __builtin_amdgcn_fence(__ATOMIC_ACQUIRE, "agent");
        xb_add(&bar[XB_XGEN(b.x)], 1u);
        asm volatile("s_waitcnt vmcnt(0)" ::: "memory");
    }
}

namespace pg8 {
constexpr int BM = 256, BK = 64, HALF = 128, HTB = HALF * BK * 2, STAGE_BYTES = 8 * HTB, NXCD = 8, WGM = 8;
__host__ __device__ __forceinline__ int lds_byte(int r, int c) { const int st = (r >> 4) * 2 + (c >> 5), rr = r & 15, cc = c & 31, ob = rr * 64 + cc * 2; return st * 1024 + (ob ^ (((ob >> 9) & 1) << 5)); }
__host__ __device__ __forceinline__ void stage_rc(int b, int& R, int& C) { const int st = b / 1024, sb = b % 1024, swz = sb ^ (((sb >> 9) & 1) << 5); R = (st >> 1) * 16 + swz / 64; C = (st & 1) * 32 + (swz % 64) / 2; }
__host__ __device__ __forceinline__ int perm32(int rho) { const int n = rho >> 4, i = rho & 15; return 8 * (i >> 2) + 4 * n + (i & 3); }
struct Unit { int pm, pn; };
struct Gemm { const bf16_t* A; const bf16_t* Bt; int M, N, K; };
struct StaticOrder {
    int nM, nN, nwg, G, c;
    __host__ __device__ void init(int M, int N, int G_, int c_) { nM = M / BM; nN = N / BM; nwg = nM * nN; G = G_; c = c_; }
    __host__ __device__ bool next(int i, Unit& u) const {
        const long L = (long)i * G + c; if (L >= nwg) return false;
        int wgid = (int)L; { const int q = nwg / NXCD, r = nwg % NXCD, xcd = wgid % NXCD, off = wgid / NXCD; wgid = (xcd < r ? xcd * (q + 1) : r * (q + 1) + (xcd - r) * q) + off; }
        const int nig = WGM * nN, gid = wgid / nig, fm = gid * WGM, gsz = (nM - fm) < WGM ? (nM - fm) : WGM;
        u.pm = fm + ((wgid % nig) % gsz); u.pn = (wgid % nig) / gsz; return true;
    }
    __device__ __forceinline__ void a_ready(const Unit&) const {}
    __device__ __forceinline__ void done(const Unit&) const {}
};

struct Order2 {
    int rd, c;
    __device__ bool next(int i, Unit& u) const {
        if (i != 0) return false;
        if (rd == 0) { const int x = c & 7, j = c >> 3; u.pm = x * 4 + (j >> 3); u.pn = j & 7; return c < 256; }
        u.pm = 32 + (c >> 3); u.pn = c & 7; return c < 32;
    }
    __device__ __forceinline__ void a_ready(const Unit&) const {}
    __device__ __forceinline__ void done(const Unit&) const {}
};
struct OrderG2 {
    int c; XcdBarrier bar; LAS unsigned* wcnt;
    __device__ bool next(int i, Unit& u) const {
        if (i == 0) { const int x = c & 7, j = c >> 3; u.pm = x * 4 + (j >> 3); u.pn = j & 7; return true; }
        if (i == 1 && c < 32) { u.pm = 32 + (c >> 3); u.pn = c & 7; return true; }
        return false;
    }
    __device__ __forceinline__ void a_ready(const Unit&) const {}
    __device__ __forceinline__ void done(const Unit& u) const {
        if (c < 32 && u.pm < 32) {
            asm volatile("s_waitcnt vmcnt(0)" ::: "memory");
            if ((threadIdx.x & 63) == 0) {
                const unsigned o = __hip_atomic_fetch_add((unsigned*)wcnt, 1u, __ATOMIC_RELAXED, __HIP_MEMORY_SCOPE_WORKGROUP);
                if (o == 7u) xcd_barrier_arrive_only(bar);
            }
        }
    }
};
struct EpiProj {
    static constexpr bool PERM = true, AFTER_DRAIN = false;
    bf16_t* sec; float* vss;
    __device__ __forceinline__ void operator()(const f32x4 (&acc)[2][2][4][2], const Unit& u, int wr, int wc, int fr, int fq) const {
        const int s = u.pn >> 2, ct = u.pn & 3;
        bf16_t* base = sec + (size_t)s * SEC_STRIDE;
        const int row0 = u.pm * BM + wr * 64 + fr, col0 = ct * 256 + wc * 32 + 8 * fq;
        const bool is_gelu = (s == 2 || s == 3);
        const float ka = is_gelu ? -2.30220819f : -1.44269504f, kb = is_gelu ? -0.10294324f : 0.0f;
#pragma unroll
        for (int ai = 0; ai < 2; ++ai)
#pragma unroll
            for (int m = 0; m < 4; ++m) {
                const int row = row0 + ai * HALF + m * 16;
                bf16_t* rowp = base + (size_t)row * 1024 + col0;
                float ss = 0.f;
#pragma unroll
                for (int bj = 0; bj < 2; ++bj) {
                    f32x4 v0 = acc[ai][bj][m][0], v1 = acc[ai][bj][m][1];
                    if (s != 0) {
#pragma unroll
                        for (int j = 0; j < 4; j += 2) { const f32x2 a = act_gate2((f32x2){v0[j], v0[j + 1]}, ka, kb), b = act_gate2((f32x2){v1[j], v1[j + 1]}, ka, kb); v0[j] = a.x; v0[j + 1] = a.y; v1[j] = b.x; v1[j + 1] = b.y; }
                    }
                    ss += (v0[0] * v0[0] + v0[1] * v0[1]) + (v0[2] * v0[2] + v0[3] * v0[3]) + (v1[0] * v1[0] + v1[1] * v1[1]) + (v1[2] * v1[2] + v1[3] * v1[3]);
                    u32x4 w; w.x = cvt_pk_bf16(v0[0], v0[1]); w.y = cvt_pk_bf16(v0[2], v0[3]); w.z = cvt_pk_bf16(v1[0], v1[1]); w.w = cvt_pk_bf16(v1[2], v1[3]);
                    *(u32x4*)(rowp + bj * HALF) = w;
                }
                if (s == 3) {
                    ss += __shfl_xor(ss, 16); ss += __shfl_xor(ss, 32);
                    if (fq == 0) vss[(size_t)row * 16 + ct * 4 + wc] = ss;
                }
            }
    }
};
struct EpiOut {
    static constexpr bool PERM = true, AFTER_DRAIN = false;
    bf16_t* O; float* oss;
    __device__ __forceinline__ void operator()(const f32x4 (&acc)[2][2][4][2], const Unit& u, int wr, int wc, int fr, int fq) const {
        const int row0 = u.pm * BM + wr * 64 + fr, col0 = u.pn * BM + wc * 32 + 8 * fq;
#pragma unroll
        for (int ai = 0; ai < 2; ++ai)
#pragma unroll
            for (int m = 0; m < 4; ++m) {
                const int row = row0 + ai * HALF + m * 16;
                bf16_t* rowp = O + (size_t)row * 2048 + col0;
                float ss = 0.f;
#pragma unroll
                for (int bj = 0; bj < 2; ++bj) {
                    const f32x4 v0 = acc[ai][bj][m][0], v1 = acc[ai][bj][m][1];
                    ss += (v0[0] * v0[0] + v0[1] * v0[1]) + (v0[2] * v0[2] + v0[3] * v0[3]) + (v1[0] * v1[0] + v1[1] * v1[1]) + (v1[2] * v1[2] + v1[3] * v1[3]);
                    u32x4 w; w.x = cvt_pk_bf16(v0[0], v0[1]); w.y = cvt_pk_bf16(v0[2], v0[3]); w.z = cvt_pk_bf16(v1[0], v1[1]); w.w = cvt_pk_bf16(v1[2], v1[3]);
                    *(u32x4*)(rowp + bj * HALF) = w;
                }
                ss += __shfl_xor(ss, 16); ss += __shfl_xor(ss, 32);
                if (fq == 0) oss[(size_t)row * 32 + u.pn * 4 + wc] = ss;
            }
    }
};

template <class Epi, class Sched>
__device__ __forceinline__ void gemm_phase(LAS unsigned char* lds, const Gemm g, const Sched& S, const Epi& E) {
    const int tid = threadIdx.x, wid = __builtin_amdgcn_readfirstlane(tid >> 6), lane = tid & 63, wr = wid >> 2, wc = wid & 3, fr = lane & 15, fq = lane >> 4;
    const int K = g.K, nt = K / BK;
    unsigned voffA[2], voffB[2];
#pragma unroll
    for (int i = 0; i < 2; ++i) { int R, C; stage_rc(tid * 16 + i * 8192, R, C); const int Rb = Epi::PERM ? ((R & ~31) + perm32(R & 31)) : R;
        voffA[i] = (unsigned)(R * K + C) * 2u; voffB[i] = (unsigned)(Rb * K + C) * 2u; }
    const size_t kstep = (size_t)(BK * 2);
    const size_t hstep = (size_t)HALF * K * 2;
    const size_t tstep = 2 * hstep;
    const unsigned ldsw = (unsigned)wid * 1024u;
    const int aoff = lds_byte(wr * 64 + fr, fq * 8), boff = lds_byte(wc * 32 + fr, fq * 8);
#define PG8_SA(b, h) (((b) * 2 + (h)) * HTB)
#define PG8_SB(b, h) ((4 + (b) * 2 + (h)) * HTB)
#define PG8_STAGE(bufoff, gbase, voff) do { _Pragma("unroll") for (int _i = 0; _i < 2; ++_i) \
        __builtin_amdgcn_global_load_lds((const unsigned*)((const char*)(gbase) + (voff)[_i]), (LAS unsigned*)(lds + (bufoff) + ldsw + _i * 8192), 16, 0, 0); } while (0)
#define PG8_LDA(dst, b, h) do { _Pragma("unroll") for (int m = 0; m < 4; ++m) _Pragma("unroll") for (int k = 0; k < 2; ++k) dst[m][k] = *(const LAS bf16x8*)(lds + PG8_SA(b, h) + aoff + m * 2048 + k * 1024); } while (0)
#define PG8_LDB(dst, b, h) do { _Pragma("unroll") for (int n = 0; n < 2; ++n) _Pragma("unroll") for (int k = 0; k < 2; ++k) dst[n][k] = *(const LAS bf16x8*)(lds + PG8_SB(b, h) + boff + n * 2048 + k * 1024); } while (0)
#define PG8_MMA(ai, bj, At, Bt) do { __builtin_amdgcn_s_setprio(1); _Pragma("unroll") for (int m = 0; m < 4; ++m) _Pragma("unroll") for (int n = 0; n < 2; ++n) _Pragma("unroll") for (int k = 0; k < 2; ++k) \
        acc[ai][bj][m][n] = __builtin_amdgcn_mfma_f32_16x16x32_bf16(Bt[n][k], At[m][k], acc[ai][bj][m][n], 0, 0, 0); __builtin_amdgcn_s_setprio(0); } while (0)
#define PG8_WAIT_V(n) asm volatile("s_waitcnt vmcnt(" #n ")" ::: "memory")
#define PG8_WAIT_L(n) asm volatile("s_waitcnt lgkmcnt(" #n ")" ::: "memory")
#define PG8_BAR __builtin_amdgcn_s_barrier()
#define PG8_SCHED __builtin_amdgcn_sched_barrier(0)
    Unit cur, nxt; int ui = 0;
    if (!S.next(0, cur)) return;
    f32x4 acc[2][2][4][2];
#pragma unroll
    for (int a = 0; a < 2; ++a)
#pragma unroll
        for (int b = 0; b < 2; ++b)
#pragma unroll
            for (int m = 0; m < 4; ++m)
#pragma unroll
                for (int n = 0; n < 2; ++n) acc[a][b][m][n] = (f32x4){0.f, 0.f, 0.f, 0.f};
    bf16x8 At[4][2], B0[2][2], B1[2][2];
    const char* cA = (const char*)g.A + (size_t)cur.pm * tstep; const char* cB = (const char*)g.Bt + (size_t)cur.pn * tstep;
    S.a_ready(cur);
    PG8_STAGE(PG8_SB(0, 0), cB, voffB); PG8_STAGE(PG8_SA(0, 0), cA, voffA); PG8_STAGE(PG8_SB(0, 1), cB + hstep, voffB); PG8_STAGE(PG8_SA(0, 1), cA + hstep, voffA);
    if (wr == 1) PG8_BAR;
    PG8_WAIT_V(4); PG8_BAR;
    PG8_STAGE(PG8_SB(1, 0), cB + kstep, voffB); PG8_STAGE(PG8_SA(1, 0), cA + kstep, voffA); PG8_STAGE(PG8_SB(1, 1), cB + hstep + kstep, voffB);
    PG8_WAIT_V(6); PG8_BAR;
    for (;;) {
        const bool has_next = S.next(ui + 1, nxt);
        const char* nA = has_next ? (const char*)g.A + (size_t)nxt.pm * tstep : cA; const char* nB = has_next ? (const char*)g.Bt + (size_t)nxt.pn * tstep : cB;
        for (int t = 0; t < nt; t += 2) {
            const bool last = (t == nt - 2);
            const char* a1 = cA + (size_t)(t + 1) * kstep;
            const char* a2 = last ? nA : cA + (size_t)(t + 2) * kstep; const char* b2 = last ? nB : cB + (size_t)(t + 2) * kstep;
            const char* a3 = a2 + kstep; const char* b3 = b2 + kstep;
            if (last && has_next) S.a_ready(nxt);
            PG8_LDB(B0, 0, 0); PG8_SCHED; PG8_LDA(At, 0, 0); PG8_STAGE(PG8_SA(1, 1), a1 + hstep, voffA);
            PG8_WAIT_L(8); PG8_BAR; PG8_WAIT_L(0); PG8_MMA(0, 0, At, B0); PG8_BAR; PG8_SCHED;
            PG8_LDB(B1, 0, 1); PG8_STAGE(PG8_SB(0, 0), b2, voffB);
            PG8_BAR; PG8_WAIT_L(0); PG8_MMA(0, 1, At, B1); PG8_BAR;
            PG8_LDA(At, 0, 1); PG8_STAGE(PG8_SA(0, 0), a2, voffA);
            PG8_BAR; PG8_WAIT_L(0); PG8_MMA(1, 0, At, B0); PG8_BAR; PG8_SCHED;
            PG8_STAGE(PG8_SB(0, 1), b2 + hstep, voffB);
            PG8_WAIT_V(6); PG8_BAR; PG8_MMA(1, 1, At, B1); PG8_BAR;
            PG8_LDB(B0, 1, 0); PG8_SCHED; PG8_LDA(At, 1, 0); PG8_STAGE(PG8_SA(0, 1), a2 + hstep, voffA);
            PG8_WAIT_L(8); PG8_BAR; PG8_WAIT_L(0); PG8_MMA(0, 0, At, B0); PG8_BAR; PG8_SCHED;
            PG8_LDB(B1, 1, 1); PG8_STAGE(PG8_SB(1, 0), b3, voffB);
            PG8_BAR; PG8_WAIT_L(0); PG8_MMA(0, 1, At, B1); PG8_BAR;
            PG8_LDA(At, 1, 1); PG8_STAGE(PG8_SA(1, 0), a3, voffA);
            PG8_BAR; PG8_WAIT_L(0); PG8_MMA(1, 0, At, B0); PG8_BAR; PG8_SCHED;
            PG8_STAGE(PG8_SB(1, 1), b3 + hstep, voffB);
            PG8_WAIT_V(6); PG8_BAR; PG8_MMA(1, 1, At, B1); PG8_BAR;
        }
        if constexpr (!Epi::AFTER_DRAIN) { E(acc, cur, wr, wc, fr, fq); S.done(cur); }
        if (!has_next) break;
#pragma unroll
        for (int a = 0; a < 2; ++a)
#pragma unroll
            for (int b = 0; b < 2; ++b)
#pragma unroll
                for (int m = 0; m < 4; ++m)
#pragma unroll
                    for (int n = 0; n < 2; ++n) acc[a][b][m][n] = (f32x4){0.f, 0.f, 0.f, 0.f};
        cur = nxt; cA = nA; cB = nB; ++ui;
    }
    PG8_WAIT_V(0);
    if (wr == 0) PG8_BAR;
    PG8_BAR;
#undef PG8_SA
#undef PG8_SB
#undef PG8_STAGE
#undef PG8_LDA
#undef PG8_LDB
#undef PG8_MMA
#undef PG8_WAIT_V
#undef PG8_WAIT_L
#undef PG8_BAR
#undef PG8_SCHED
}
}

constexpr int CVT_NT1 = 32 * 160, CVT_NT2 = 32 * 64;
__device__ __forceinline__ void convert_weights(const Params& p, int t_lo, int t_hi, int gw, int nw) {
    const int lane = threadIdx.x & 63, kg = lane & 7, nq = lane >> 3;
    unsigned char* ws = p.ws;
    for (int wt = t_lo + gw; wt < t_hi; wt += 2 * nw) {
        f32x4 v[2][8]; bf16_t* dstp[2]; bool ok[2];
#pragma unroll
        for (int u = 0; u < 2; ++u) {
            const int w_ = wt + u * nw; ok[u] = w_ < t_hi;
            const int w2 = ok[u] ? w_ : wt;
            const float* src; bf16_t* dst; int ldn, kt, nt;
            if (w2 < CVT_NT1) { src = p.in[6]; dst = (bf16_t*)(ws + WS_BT1); ldn = PW; kt = w2 / 160; nt = w2 % 160; }
            else { const int t2 = w2 - CVT_NT1; src = p.in[17]; dst = (bf16_t*)(ws + WS_BT2); ldn = 2048; kt = t2 / 64; nt = t2 % 64; }
            const int k0 = kt * 64 + 8 * kg, n = nt * 32 + 4 * nq;
            const float* sp = src + (size_t)k0 * ldn + n;
#pragma unroll
            for (int r = 0; r < 8; ++r) v[u][r] = __builtin_nontemporal_load((const f32x4*)(sp + (size_t)r * ldn));
            dstp[u] = dst + (size_t)n * 2048 + k0;
        }
#pragma unroll
        for (int u = 0; u < 2; ++u) {
            if (ok[u]) {
#pragma unroll
                for (int j = 0; j < 4; ++j) {
                    u32x4 w; w.x = cvt_pk_bf16(v[u][0][j], v[u][1][j]); w.y = cvt_pk_bf16(v[u][2][j], v[u][3][j]); w.z = cvt_pk_bf16(v[u][4][j], v[u][5][j]); w.w = cvt_pk_bf16(v[u][6][j], v[u][7][j]);
                    *(u32x4*)(dstp[u] + (size_t)j * 2048) = w;
                }
            }
        }
    }
}

__device__ __forceinline__ void convert_small_weights(const Params& p, int t0, int nt) {
    unsigned char* ws = p.ws;
    {
        const int total = 2 * 8 * 16 * 128;
        for (int idx = t0; idx < total; idx += nt) {
            const int j = idx & 127, k8 = (idx >> 7) & 15, h = (idx >> 11) & 7, which = idx >> 14;
            const float* w = (which ? p.in[11] : p.in[9]) + (size_t)h * 128 * 128;
            float f[8];
#pragma unroll
            for (int i = 0; i < 8; ++i) f[i] = w[(k8 * 8 + i) * 128 + j];
            u32x4 o; o.x = cvt_pk_bf16(f[0], f[1]); o.y = cvt_pk_bf16(f[2], f[3]); o.z = cvt_pk_bf16(f[4], f[5]); o.w = cvt_pk_bf16(f[6], f[7]);
            bf16_t* dst = (bf16_t*)(ws + (which ? WS_WIT : WS_WRT));
            *(u32x4*)(dst + ((size_t)h * 128 + j) * 128 + k8 * 8) = o;
        }
    }
    {
        const int total = 2 * 8 * 128 * 16;
        for (int idx = t0; idx < total; idx += nt) {
            const int s8 = (idx & 15) * 8, t = (idx >> 4) & 127, h = (idx >> 11) & 7, which = idx >> 14;
            const float* w = p.in[15] + (size_t)h * 128 * 128;
            float f[8];
#pragma unroll
            for (int i = 0; i < 8; ++i) {
                if (!which) f[i] = (s8 + i <= t) ? w[t * 128 + s8 + i] : 0.f;
                else f[i] = ((s8 >> 3) == (t >> 3) && i <= (t & 7)) ? w[(t & 7) * 128 + i] : 0.f;
            }
            u32x4 o; o.x = cvt_pk_bf16(f[0], f[1]); o.y = cvt_pk_bf16(f[2], f[3]); o.z = cvt_pk_bf16(f[4], f[5]); o.w = cvt_pk_bf16(f[6], f[7]);
            bf16_t* dst = (bf16_t*)(ws + (which ? WS_WMS : WS_WMP));
            *(u32x4*)(dst + ((size_t)h * 128 + t) * 128 + s8) = o;
        }
    }
}

__device__ __forceinline__ void p0_prep(const Params& p, LAS unsigned char* lds) {
    const int tid = threadIdx.x, lane = tid & 63, wid = tid >> 6;
    unsigned char* ws = p.ws;
    convert_weights(p, 0, (gridDim.x == 256) ? CVT_NT1 : CVT_NT1 + CVT_NT2, blockIdx.x * 8 + wid, gridDim.x * 8);
    if (gridDim.x != 256) convert_small_weights(p, blockIdx.x * 512 + tid, gridDim.x * 512);
    {
        bf16_t* zb = (bf16_t*)(ws + WS_ZB);
        const float* gpre = p.in[4];
        f32x4 gg[8];
#pragma unroll
        for (int i = 0; i < 8; ++i) gg[i] = *(const f32x4*)(gpre + (lane + 64 * i) * 4);
        for (int row = blockIdx.x * 8 + wid; row < MT; row += gridDim.x * 8) {
            const float* xr = row < MP ? p.in[0] + (size_t)row * 2048 : p.in[1] + (size_t)(row - MP) * 2048;
            f32x4 v[8]; float ss = 0.f;
#pragma unroll
            for (int i = 0; i < 8; ++i) { v[i] = __builtin_nontemporal_load((const f32x4*)(xr + (lane + 64 * i) * 4)); ss += (v[i][0] * v[i][0] + v[i][1] * v[i][1]) + (v[i][2] * v[i][2] + v[i][3] * v[i][3]); }
#pragma unroll
            for (int o = 32; o >= 1; o >>= 1) ss += __shfl_xor(ss, o);
            const float rs = rsqrtf(ss * (1.0f / 2048.0f) + EPS);
#pragma unroll
            for (int i = 0; i < 8; ++i) {
                u32x2 w; w.x = cvt_pk_bf16(v[i][0] * rs * gg[i][0], v[i][1] * rs * gg[i][1]); w.y = cvt_pk_bf16(v[i][2] * rs * gg[i][2], v[i][3] * rs * gg[i][3]);
                *(u32x2*)(zb + (size_t)row * 2048 + (lane + 64 * i) * 4) = w;
            }
        }
    }
}

constexpr int XCB_LD = 136, XCF_LD = 132, XCF_OFF = 128 * XCB_LD * 2, HIN_OFF = XCF_OFF + 128 * XCF_LD * 4, CW_OFF = HIN_OFF + 512;
__device__ __forceinline__ void unpack8(const u32x4 w, float (&f)[8]) { f[0] = bf_lo(w.x); f[1] = bf_hi(w.x); f[2] = bf_lo(w.y); f[3] = bf_hi(w.y); f[4] = bf_lo(w.z); f[5] = bf_hi(w.z); f[6] = bf_lo(w.w); f[7] = bf_hi(w.w); }
struct LruIn { u32x4 xw[7]; };
template <int MODE>
__device__ __forceinline__ void lru_load(const Params& p, int g, int h, LruIn& R) {
    int tid_ = threadIdx.x; asm volatile("" : "+v"(tid_));
    const int tid = tid_, lane = tid & 63, wid = __builtin_amdgcn_readfirstlane(tid >> 6), fr = lane & 15, fq = lane >> 4;
    unsigned char* ws = p.ws;
    const bf16_t* XR = (const bf16_t*)(ws + WS_SEC);
    const bf16_t* SGR = XR + SEC_STRIDE;
    const int row0 = g * 128, ch0 = h * 128;
    constexpr bool samp = (MODE == 1), fused = (MODE == 2);
    const int c = g & 15, ns0 = (g - NGRP_P) * 16;
    const int rg = tid >> 4, c8 = (tid & 15) * 8, chl = 16 * wid + fr;
#pragma unroll
    for (int k = 0; k < 7; ++k) {
        const int rr = 4 * rg + k - 3;
        if (samp && k < 3 && (rg & 1) == 0) {
            const float* st = p.in[2] + ((size_t)(ns0 + (rg >> 1)) * 3 + k) * 1024 + ch0 + c8;
            const f32x4 a = *(const f32x4*)st, b = *(const f32x4*)(st + 4);
            R.xw[k].x = cvt_pk_bf16(a[0], a[1]); R.xw[k].y = cvt_pk_bf16(a[2], a[3]); R.xw[k].z = cvt_pk_bf16(b[0], b[1]); R.xw[k].w = cvt_pk_bf16(b[2], b[3]);
        } else if (samp || c * 128 + rr >= 0) {
            R.xw[k] = __builtin_nontemporal_load((const u32x4*)(XR + (size_t)(row0 + rr) * 1024 + ch0 + c8));
        } else R.xw[k] = (u32x4){0u, 0u, 0u, 0u};
    }
}
template <int MODE>
__device__ __forceinline__ void lru_unit(const Params& p, LAS unsigned char* lds, int g, int h, LruIn& IN, bool pf_next, int gn, int hn, LruIn& NX, const float c_r, const float c_i, const float spl) {
    int tid_ = threadIdx.x; asm volatile("" : "+v"(tid_));
    const int tid = tid_, lane = tid & 63, wid = __builtin_amdgcn_readfirstlane(tid >> 6), fr = lane & 15, fq = lane >> 4;
    unsigned char* ws = p.ws;
    const bf16_t* XR = (const bf16_t*)(ws + WS_SEC);
    const bf16_t* SGR = XR + SEC_STRIDE;
    bf16_t* A2 = (bf16_t*)(ws + WS_A2);
    float* AGG = (float*)(ws + WS_AGG);
    unsigned* AB = (unsigned*)(ws + WS_AB);
    LAS bf16_t* XCB = (LAS bf16_t*)lds;
    LAS float* XCF = (LAS float*)(lds + XCF_OFF);
    const int row0 = g * 128, ch0 = h * 128;
    constexpr bool samp = (MODE == 1), fused = (MODE == 2);
    const int c = g & 15, nseq = g >> 4;
    const int ns0 = (g - NGRP_P) * 16;
    const int rg = tid >> 4, c8 = (tid & 15) * 8;
    const int lrow0 = 16 * (rg & 7) + 4 * (rg >> 3);
    const int chl = 16 * wid + fr, ch = ch0 + chl;
    bf16x8 br[4], bi[4];
    {
        const bf16_t* WRT = (const bf16_t*)(ws + WS_WRT) + ((size_t)h * 128 + chl) * 128 + 8 * fq;
        const bf16_t* WIT = (const bf16_t*)(ws + WS_WIT) + ((size_t)h * 128 + chl) * 128 + 8 * fq;
#pragma unroll
        for (int ks = 0; ks < 4; ++ks) { br[ks] = *(const bf16x8*)(WRT + 32 * ks); bi[ks] = *(const bf16x8*)(WIT + 32 * ks); }
    }
    float h0v[4];
    u32x4 sgrk[4];
    if (samp || fused) {
#pragma unroll
        for (int i = 0; i < 4; ++i) sgrk[i] = __builtin_nontemporal_load((const u32x4*)(SGR + (size_t)(row0 + 4 * rg + i) * 1024 + ch0 + c8));
    }
    if (samp) {
#pragma unroll
        for (int k = 0; k < 4; ++k) h0v[k] = p.in[3][(size_t)(ns0 + 4 * fq + k) * 1024 + ch];
    }
    {
        {
            const bool tail = samp ? ((rg & 1) != 0) : (c == 15 && rg == 31);
            if (tail) {
                float* dst = samp ? p.out + O_CONVS + ((size_t)(ns0 + (rg >> 1)) * 3) * 1024 + ch0 + c8 : p.out + O_CONVP + ((size_t)nseq * 3) * 1024 + ch0 + c8;
#pragma unroll
                for (int k = 4; k < 7; ++k) { float f[8]; unpack8(IN.xw[k], f); *(f32x4*)(dst + (k - 4) * 1024) = (f32x4){f[0], f[1], f[2], f[3]}; *(f32x4*)(dst + (k - 4) * 1024 + 4) = (f32x4){f[4], f[5], f[6], f[7]}; }
            }
        }
        float acc[4][8];
        {
            const LAS float* CWL = (const LAS float*)(lds + CW_OFF);
            const f32x4 a = *(const LAS f32x4*)(CWL + c8), b = *(const LAS f32x4*)(CWL + c8 + 4);
#pragma unroll
            for (int i = 0; i < 4; ++i) { acc[i][0] = a[0]; acc[i][1] = a[1]; acc[i][2] = a[2]; acc[i][3] = a[3]; acc[i][4] = b[0]; acc[i][5] = b[1]; acc[i][6] = b[2]; acc[i][7] = b[3]; }
        }
#pragma unroll
        for (int kw = 0; kw < 4; ++kw) {
            const LAS float* CWL = (const LAS float*)(lds + CW_OFF) + 128 * (kw + 1);
            const f32x4 a = *(const LAS f32x4*)(CWL + c8), b = *(const LAS f32x4*)(CWL + c8 + 4);
            const float cw[8] = {a[0], a[1], a[2], a[3], b[0], b[1], b[2], b[3]};
#pragma unroll
            for (int i = 0; i < 4; ++i) { float f[8]; unpack8(IN.xw[i + kw], f);
#pragma unroll
                for (int e = 0; e < 8; ++e) acc[i][e] += cw[e] * f[e]; }
        }
#pragma unroll
        for (int i = 0; i < 4; ++i) {
            const int r = lrow0 + i;
            u32x4 w; w.x = cvt_pk_bf16(acc[i][0], acc[i][1]); w.y = cvt_pk_bf16(acc[i][2], acc[i][3]); w.z = cvt_pk_bf16(acc[i][4], acc[i][5]); w.w = cvt_pk_bf16(acc[i][6], acc[i][7]);
            *(LAS u32x4*)(XCB + r * XCB_LD + c8) = w;
            *(LAS f32x4*)(XCF + r * XCF_LD + c8) = (f32x4){acc[i][0], acc[i][1], acc[i][2], acc[i][3]};
            *(LAS f32x4*)(XCF + r * XCF_LD + c8 + 4) = (f32x4){acc[i][4], acc[i][5], acc[i][6], acc[i][7]};
        }
    }
    __syncthreads();
    f32x4 ar[8], ai[8];
#pragma unroll
    for (int m = 0; m < 8; ++m) { ar[m] = (f32x4){0.f, 0.f, 0.f, 0.f}; ai[m] = (f32x4){0.f, 0.f, 0.f, 0.f}; }
#pragma unroll
    for (int m = 0; m < 8; ++m)
#pragma unroll
        for (int ks = 0; ks < 4; ++ks) {
            const bf16x8 a = *(const LAS bf16x8*)(XCB + (16 * m + fr) * XCB_LD + 32 * ks + 8 * fq);
            ar[m] = __builtin_amdgcn_mfma_f32_16x16x32_bf16(a, br[ks], ar[m], 0, 0, 0);
            ai[m] = __builtin_amdgcn_mfma_f32_16x16x32_bf16(a, bi[ks], ai[m], 0, 0, 0);
        }
    constexpr float L2E = 1.44269504f;
    float A = 1.f, B = 0.f;
#pragma unroll
    for (int m = 0; m < 8; ++m) {
#pragma unroll
        for (int jp = 0; jp < 4; jp += 2) {
            const f32x2 zr = (f32x2){ar[m][jp], ar[m][jp + 1]} * (-L2E) + c_r, zi = (f32x2){ai[m][jp], ai[m][jp + 1]} * (-L2E) + c_i;
            f32x2 er, ei; er.x = fast_exp2(zr.x); er.y = fast_exp2(zr.y); ei.x = fast_exp2(zi.x); ei.y = fast_exp2(zi.y);
            const f32x2 dr = er + 1.0f, di = ei + 1.0f;
            f32x2 rr, ii; rr.x = fast_rcp(dr.x); rr.y = fast_rcp(dr.y); ii.x = fast_rcp(di.x); ii.y = fast_rcp(di.y);
            f32x2 la = rr * spl;
            f32x2 a; a.x = fast_exp2(la.x); a.y = fast_exp2(la.y);
            const f32x2 om = 1.0f - a * a;
            f32x2 mult; mult.x = __builtin_amdgcn_sqrtf(om.x); mult.y = __builtin_amdgcn_sqrtf(om.y);
            const f32x2 xc = (f32x2){XCF[(16 * m + 4 * fq + jp) * XCF_LD + chl], XCF[(16 * m + 4 * fq + jp + 1) * XCF_LD + chl]};
            if (!samp && m == 0 && jp == 0) { if (c == 0 && fq == 0) { a.x = 0.f; mult.x = 1.f; la.x = -INFINITY; } }
            f32x2 b = mult * ii * xc;
            if (samp && jp == 0 && (m & 1) == 0) { b.x += a.x * h0v[m >> 1]; a.x = 0.f; }
            B = a.x * B + b.x; A = a.x * A;
            if (MODE == 0) AB[(size_t)(row0 + 32 * fq + 4 * m + jp) * 1024 + ch] = cvt_pk_bf16(la.x, b.x);
            else { ar[m][jp] = A; ai[m][jp] = B; }
            B = a.y * B + b.y; A = a.y * A;
            if (MODE == 0) AB[(size_t)(row0 + 32 * fq + 4 * m + jp + 1) * 1024 + ch] = cvt_pk_bf16(la.y, b.y);
            else { ar[m][jp + 1] = A; ai[m][jp + 1] = B; }
        }
    }
    if (pf_next) lru_load<MODE>(p, gn, hn, NX);
    if (MODE == 0) {
        float Ai = A, Bi = B;
        { const float sa = __shfl_up(Ai, 16), sb = __shfl_up(Bi, 16); if (fq >= 1) { Bi = Ai * sb + Bi; Ai = sa * Ai; } }
        { const float sa = __shfl_up(Ai, 32), sb = __shfl_up(Bi, 32); if (fq >= 2) { Bi = Ai * sb + Bi; Ai = sa * Ai; } }
        if (fq == 3) { float* a = AGG + ((size_t)(g * 8 + h)) * 256 + chl; a[0] = Ai; a[128] = Bi; }
        __syncthreads();
        return;
    }
    if (fused) {
        float Ai = A, Bi = B;
        { const float sa = __shfl_up(Ai, 16), sb = __shfl_up(Bi, 16); if (fq >= 1) { Bi = Ai * sb + Bi; Ai = sa * Ai; } }
        { const float sa = __shfl_up(Ai, 32), sb = __shfl_up(Bi, 32); if (fq >= 2) { Bi = Ai * sb + Bi; Ai = sa * Ai; } }
        float ea = __shfl_up(Ai, 16), eb = __shfl_up(Bi, 16); if (fq == 0) { ea = 1.f; eb = 0.f; }
        unsigned long long* GR = (unsigned long long*)(ws + WS_AGG);
        if (fq == 3) __hip_atomic_store(GR + ((size_t)(g * 8 + h)) * 128 + chl, ((unsigned long long)__float_as_uint(Bi) << 32) | (unsigned long long)(__float_as_uint(Ai) | 0x80000000u), __ATOMIC_RELAXED, __HIP_MEMORY_SCOPE_AGENT);
        if (tid < 128 && c > 0) {
            const unsigned long long* gp = GR + ((size_t)(nseq * 16) * 8 + h) * 128 + tid;
            unsigned long long gv[15]; unsigned polls = 0;
            for (;;) {
                bool ok = true;
#pragma unroll
                for (int cc = 0; cc < 15; ++cc) { const int ci = cc < c ? cc : 0; gv[cc] = __hip_atomic_load(gp + (size_t)ci * 1024, __ATOMIC_RELAXED, __HIP_MEMORY_SCOPE_AGENT); }
#pragma unroll
                for (int cc = 0; cc < 15; ++cc) ok = ok && ((int)(unsigned)gv[cc] < 0);
                if (__all(ok) || ++polls > (1u << 18)) break;
                __builtin_amdgcn_s_sleep(1);
            }
            float Hc = 0.f;
#pragma unroll
            for (int cc = 0; cc < 15; ++cc) Hc = (cc < c) ? __uint_as_float((unsigned)(gv[cc] >> 32)) + __uint_as_float((unsigned)gv[cc] & 0x7fffffffu) * Hc : Hc;
            ((LAS float*)(lds + HIN_OFF))[tid] = Hc;
        }
        __syncthreads();
        const float Hin = c > 0 ? ((LAS float*)(lds + HIN_OFF))[chl] : 0.f;
        const float hs = eb + ea * Hin;
#pragma unroll
        for (int m = 0; m < 8; ++m)
#pragma unroll
            for (int j = 0; j < 4; ++j) ai[m][j] = ai[m][j] + ar[m][j] * hs;
    }
#pragma unroll
    for (int m = 0; m < 8; ++m)
#pragma unroll
        for (int j = 0; j < 4; ++j) XCF[(16 * m + 4 * fq + j) * XCF_LD + chl] = ai[m][j];
    __syncthreads();
    {
#pragma unroll
        for (int i = 0; i < 4; ++i) {
            const int r = 4 * rg + i, lr = lrow0 + i;
            const f32x4 h0 = *(const LAS f32x4*)(XCF + lr * XCF_LD + c8), h1 = *(const LAS f32x4*)(XCF + lr * XCF_LD + c8 + 4);
            const u32x4 gw = sgrk[i];
            u32x4 w; w.x = cvt_pk_bf16(h0[0] * bf_lo(gw.x), h0[1] * bf_hi(gw.x)); w.y = cvt_pk_bf16(h0[2] * bf_lo(gw.y), h0[3] * bf_hi(gw.y));
            w.z = cvt_pk_bf16(h1[0] * bf_lo(gw.z), h1[1] * bf_hi(gw.z)); w.w = cvt_pk_bf16(h1[2] * bf_lo(gw.w), h1[3] * bf_hi(gw.w));
            *(u32x4*)(A2 + (size_t)(row0 + r) * 2048 + ch0 + c8) = w;
            if (samp) { if (i == 3 && (rg & 1) != 0) { float* dst = p.out + O_HS + (size_t)(ns0 + (rg >> 1)) * 1024 + ch0 + c8; *(f32x4*)dst = h0; *(f32x4*)(dst + 4) = h1; } }
            else { if (i == 3 && c == 15 && rg == 31) { float* dst = p.out + O_HP + (size_t)nseq * 1024 + ch0 + c8; *(f32x4*)dst = h0; *(f32x4*)(dst + 4) = h1; } }
        }
    }
    __syncthreads();
}

template <int MODE>
__device__ __forceinline__ void lru_run(const Params& p, LAS unsigned char* lds, int first, int count, int stride, int gofs) {
    LruIn La, Lb;
    const int u0 = first, u1 = first + stride, u2 = first + 2 * stride;
    lru_load<MODE>(p, gofs + (u0 >> 3), u0 & 7, La);
    if (threadIdx.x < 160) {
        const int k = threadIdx.x >> 5, c4 = (threadIdx.x & 31) * 4;
        const float* src = (k == 0 ? p.in[8] : p.in[7] + (k - 1) * 1024) + (u0 & 7) * 128 + c4;
        *(LAS f32x4*)((LAS float*)(lds + CW_OFF) + 128 * k + c4) = *(const f32x4*)src;
    }
    __syncthreads();
    constexpr float L2E = 1.44269504f;
    const int chn = (u0 & 7) * 128 + 16 * (int)(threadIdx.x >> 6) + (int)(threadIdx.x & 15);
    const float c_r = -L2E * p.in[10][chn], c_i = -L2E * p.in[12][chn];
    float spl;
    { const float nl = -p.in[13][chn]; spl = -8.0f * L2E * (fmaxf(nl, 0.f) + log1pf(__expf(-fabsf(nl)))); }
    lru_unit<MODE>(p, lds, gofs + (u0 >> 3), u0 & 7, La, count > 1, gofs + (u1 >> 3), u1 & 7, Lb, c_r, c_i, spl);
    if (count > 1) {
        lru_unit<MODE>(p, lds, gofs + (u1 >> 3), u1 & 7, Lb, count > 2, gofs + (u2 >> 3), u2 & 7, La, c_r, c_i, spl);
        if (count > 2) lru_unit<MODE>(p, lds, gofs + (u2 >> 3), u2 & 7, La, false, 0, 0, Lb, c_r, c_i, spl);
    }
}

__device__ __forceinline__ void lru_pass2_unit(const Params& p, LAS unsigned char* lds, int g, int h) {
    int tid_ = threadIdx.x; asm volatile("" : "+v"(tid_));
    const int tid = tid_, q = __builtin_amdgcn_readfirstlane(tid >> 6), cp = (tid & 63) * 2;
    unsigned char* ws = p.ws;
    const bf16_t* SGR = (const bf16_t*)(ws + WS_SEC) + SEC_STRIDE;
    bf16_t* A2 = (bf16_t*)(ws + WS_A2);
    const float* AGG = (const float*)(ws + WS_AGG);
    const unsigned* AB = (const unsigned*)(ws + WS_AB);
    LAS float* HIN = (LAS float*)lds;
    LAS float* TOT = (LAS float*)(lds + 512);
    const int row0 = g * 128, ch0 = h * 128, c = g & 15, nseq = g >> 4;
    u32x2 ab[16]; unsigned sg[16];
#pragma unroll
    for (int r = 0; r < 16; ++r) {
        ab[r] = __builtin_nontemporal_load((const u32x2*)(AB + (size_t)(row0 + 16 * q + r) * 1024 + ch0 + cp));
        sg[r] = __builtin_nontemporal_load((const unsigned*)(SGR + (size_t)(row0 + 16 * q + r) * 1024 + ch0 + cp));
    }
    if (tid < 128) {
        const float* a = AGG + ((size_t)(nseq * 16) * 8 + h) * 256 + tid;
        float H = 0.f;
#pragma unroll
        for (int c0 = 0; c0 < 15; c0 += 5) {
            float Pv[5], Bv[5];
#pragma unroll
            for (int cc = 0; cc < 5; ++cc) { const int ci = (c0 + cc) < c ? (c0 + cc) : 0; Pv[cc] = a[(size_t)ci * 2048]; Bv[cc] = a[(size_t)ci * 2048 + 128]; }
#pragma unroll
            for (int cc = 0; cc < 5; ++cc) H = ((c0 + cc) < c) ? Bv[cc] + Pv[cc] * H : H;
        }
        HIN[tid] = H;
    }
    float av0[16], av1[16];
    float A0 = 1.f, B0 = 0.f, A1 = 1.f, B1 = 0.f;
#pragma unroll
    for (int r = 0; r < 16; ++r) {
        av0[r] = fast_exp2(bf_lo(ab[r].x)); av1[r] = fast_exp2(bf_lo(ab[r].y));
        B0 = av0[r] * B0 + bf_hi(ab[r].x); A0 *= av0[r];
        B1 = av1[r] * B1 + bf_hi(ab[r].y); A1 *= av1[r];
    }
    TOT[(q * 2 + 0) * 128 + cp] = A0; TOT[(q * 2 + 0) * 128 + cp + 1] = A1;
    TOT[(q * 2 + 1) * 128 + cp] = B0; TOT[(q * 2 + 1) * 128 + cp + 1] = B1;
    __syncthreads();
    float H0 = HIN[cp], H1 = HIN[cp + 1];
    for (int qq = 0; qq < q; ++qq) {
        H0 = TOT[(qq * 2 + 1) * 128 + cp] + TOT[(qq * 2 + 0) * 128 + cp] * H0;
        H1 = TOT[(qq * 2 + 1) * 128 + cp + 1] + TOT[(qq * 2 + 0) * 128 + cp + 1] * H1;
    }
#pragma unroll
    for (int r = 0; r < 16; ++r) {
        H0 = av0[r] * H0 + bf_hi(ab[r].x); H1 = av1[r] * H1 + bf_hi(ab[r].y);
        *(unsigned*)(A2 + (size_t)(row0 + 16 * q + r) * 2048 + ch0 + cp) = cvt_pk_bf16(H0 * bf_lo(sg[r]), H1 * bf_hi(sg[r]));
    }
    if (c == 15 && q == 7) { *(f32x2*)(p.out + O_HP + (size_t)nseq * 1024 + ch0 + cp) = (f32x2){H0, H1}; }
    __syncthreads();
}


struct SguRegs { bf16x8 wfrag[4]; u32x4 gu[4], sg[4]; float bias; u32x4 gv[4]; float q[4]; f32x4 g0, g1; };
template <bool EARLY, bool LATE>
__device__ __forceinline__ void sgu_stage1a(const Params& p, int g, int h, SguRegs& R) {
    int tid_ = threadIdx.x; asm volatile("" : "+v"(tid_));
    const int tid = tid_, lane = tid & 63, wid = __builtin_amdgcn_readfirstlane(tid >> 6), fr = lane & 15, fq = lane >> 4;
    unsigned char* ws = p.ws;
    const bf16_t* GU = (const bf16_t*)(ws + WS_SEC) + 2 * SEC_STRIDE;
    const bf16_t* GV = GU + SEC_STRIDE;
    const bf16_t* SGS = GV + SEC_STRIDE;
    const float* VSS = (const float*)(ws + WS_VSS);
    const int row0 = g * 128, d0 = h * 128;
    const bool samp = g >= NGRP_P;
    const int d8 = (tid & 15) * 8, sb = tid >> 4;
    if (EARLY) {
#pragma unroll
        for (int it = 0; it < 4; ++it) R.gv[it] = __builtin_nontemporal_load((const u32x4*)(GV + (size_t)(row0 + sb + 32 * it) * 1024 + d0 + d8));
#pragma unroll
        for (int it = 0; it < 4; ++it) R.q[it] = VSS[(size_t)(row0 + sb + 32 * it) * 16 + (tid & 15)];
        R.g0 = *(const f32x4*)(p.in[14] + d0 + d8); R.g1 = *(const f32x4*)(p.in[14] + d0 + d8 + 4);
    }
    if (LATE) {
        const bf16_t* WM = (const bf16_t*)(ws + (samp ? WS_WMS : WS_WMP)) + ((size_t)h * 128 + 16 * wid + fr) * 128 + 8 * fq;
#pragma unroll
        for (int ks = 0; ks < 4; ++ks) R.wfrag[ks] = *(const bf16x8*)(WM + 32 * ks);
        const int t = 16 * wid + fr, row = row0 + t;
#pragma unroll
        for (int k = 0; k < 4; ++k) { const int col = d0 + 32 * k + 8 * fq; R.gu[k] = __builtin_nontemporal_load((const u32x4*)(GU + (size_t)row * 1024 + col)); R.sg[k] = __builtin_nontemporal_load((const u32x4*)(SGS + (size_t)row * 1024 + col)); }
        R.bias = p.in[16][h * 128 + (samp ? (t & 7) : t)];
    }
}
__device__ __forceinline__ void sgu_stage1b(const Params& p, LAS unsigned char* lds, int g, int h, int vt_off, SguRegs& R) {
    int tid_ = threadIdx.x; asm volatile("" : "+v"(tid_));
    const int tid = tid_;
    LAS bf16_t* VT = (LAS bf16_t*)(lds + vt_off);
    const int row0 = g * 128, d0 = h * 128;
    const bool samp = g >= NGRP_P;
    const int d8 = (tid & 15) * 8, sb = tid >> 4;
    float rsv[4];
#pragma unroll
    for (int it = 0; it < 4; ++it) {
        float q = R.q[it];
        q += __shfl_xor(q, 1); q += __shfl_xor(q, 2); q += __shfl_xor(q, 4); q += __shfl_xor(q, 8);
        rsv[it] = rsqrtf(q * (1.0f / 1024.0f) + EPS);
    }
    const float gg[8] = {R.g0[0], R.g0[1], R.g0[2], R.g0[3], R.g1[0], R.g1[1], R.g1[2], R.g1[3]};
#pragma unroll
    for (int it = 0; it < 4; ++it) {
        const int s = sb + 32 * it;
        const float rs = rsv[it];
        float f[8]; unpack8(R.gv[it], f);
#pragma unroll
        for (int i = 0; i < 8; ++i) f[i] = f[i] * rs * gg[i];
        if (samp) {
            float* dst = p.out + O_V + (size_t)(row0 - MP + s) * 1024 + d0 + d8;
            *(f32x4*)dst = (f32x4){f[0], f[1], f[2], f[3]}; *(f32x4*)(dst + 4) = (f32x4){f[4], f[5], f[6], f[7]};
        }
        const int scol = (((s >> 3) ^ (tid & 15)) << 3) + (s & 7);
#pragma unroll
        for (int i = 0; i < 8; i += 2) { const unsigned pk = cvt_pk_bf16(f[i], f[i + 1]); VT[(d8 + i) * 136 + scol] = (bf16_t)(pk & 0xffffu); VT[(d8 + i + 1) * 136 + scol] = (bf16_t)(pk >> 16); }
    }
}
__device__ __forceinline__ void sgu_stage2(const Params& p, LAS unsigned char* lds, int g, int h, int vt_off, const SguRegs& R) {
    int tid_ = threadIdx.x; asm volatile("" : "+v"(tid_));
    const int tid = tid_, lane = tid & 63, wid = __builtin_amdgcn_readfirstlane(tid >> 6), fr = lane & 15, fq = lane >> 4;
    bf16_t* A2 = (bf16_t*)(p.ws + WS_A2);
    const LAS bf16_t* VT = (const LAS bf16_t*)(lds + vt_off);
    const int row = g * 128 + 16 * wid + fr, d0 = h * 128;
    f32x4 acc[8];
#pragma unroll
    for (int n = 0; n < 8; ++n) acc[n] = (f32x4){0.f, 0.f, 0.f, 0.f};
    const int ksmax = wid >> 1;
    int frv = fr; asm volatile("" : "+v"(frv));
#pragma unroll
    for (int ks = 0; ks < 4; ++ks) {
        if (ks <= ksmax) {
#pragma unroll
            for (int n = 0; n < 8; ++n) {
                const int dr = 32 * (n >> 1) + 8 * (frv >> 2) + 4 * (n & 1) + (frv & 3);
                const bf16x8 vfrag = *(const LAS bf16x8*)(VT + dr * 136 + (((4 * ks + fq) ^ (4 * (n >> 1) + (frv >> 2))) << 3));
                acc[n] = __builtin_amdgcn_mfma_f32_16x16x32_bf16(vfrag, R.wfrag[ks], acc[n], 0, 0, 0);
            }
        }
    }
    const float bias = R.bias;
#pragma unroll
    for (int k = 0; k < 4; ++k) {
        const int col = d0 + 32 * k + 8 * fq;
        const f32x4 a0 = acc[2 * k], a1 = acc[2 * k + 1];
        u32x4 w;
        w.x = cvt_pk_bf16((a0[0] + bias) * bf_lo(R.gu[k].x) * bf_lo(R.sg[k].x), (a0[1] + bias) * bf_hi(R.gu[k].x) * bf_hi(R.sg[k].x));
        w.y = cvt_pk_bf16((a0[2] + bias) * bf_lo(R.gu[k].y) * bf_lo(R.sg[k].y), (a0[3] + bias) * bf_hi(R.gu[k].y) * bf_hi(R.sg[k].y));
        w.z = cvt_pk_bf16((a1[0] + bias) * bf_lo(R.gu[k].z) * bf_lo(R.sg[k].z), (a1[1] + bias) * bf_hi(R.gu[k].z) * bf_hi(R.sg[k].z));
        w.w = cvt_pk_bf16((a1[2] + bias) * bf_lo(R.gu[k].w) * bf_lo(R.sg[k].w), (a1[3] + bias) * bf_hi(R.gu[k].w) * bf_hi(R.sg[k].w));
        *(u32x4*)(A2 + (size_t)row * 2048 + 1024 + col) = w;
    }
}
__device__ __forceinline__ void sgu_run(const Params& p, LAS unsigned char* lds, int first, int count, int stride) {
    SguRegs Ra, Rb;
    if (count <= 0) return;
    sgu_stage1a<true, true>(p, first >> 3, first & 7, Ra);
#pragma unroll 1
    for (int k = 0; k < count; k += 2) {
        const int u0 = first + k * stride, u1 = u0 + stride;
        const bool has1 = (k + 1) < count, has2 = (k + 2) < count;
        if (has1) sgu_stage1a<true, true>(p, u1 >> 3, u1 & 7, Rb);
        sgu_stage1b(p, lds, u0 >> 3, u0 & 7, 0, Ra);
        __syncthreads();
        sgu_stage2(p, lds, u0 >> 3, u0 & 7, 0, Ra);
        if (!has1) break;
        if (has2) { const int u2 = u1 + stride; sgu_stage1a<true, true>(p, u2 >> 3, u2 & 7, Ra); }
        sgu_stage1b(p, lds, u1 >> 3, u1 & 7, 34816, Rb);
        __syncthreads();
        sgu_stage2(p, lds, u1 >> 3, u1 & 7, 34816, Rb);
    }
}


__device__ __forceinline__ void p5_final(const Params& p, int row_lo, int row_hi, int worker, int nworkers) {
    const int tid = threadIdx.x, lane = tid & 63, wid = tid >> 6;
    const bf16_t* OB = (const bf16_t*)(p.ws + WS_OUTB);
    const float* OSS = (const float*)(p.ws + WS_OSS);
    const float* gpost = p.in[5];
    f32x4 gA[4], gB[4];
#pragma unroll
    for (int i = 0; i < 4; ++i) { const int col = (lane + 64 * i) * 8; gA[i] = *(const f32x4*)(gpost + col); gB[i] = *(const f32x4*)(gpost + col + 4); }
    for (int row = row_lo + worker * 8 + wid; row < row_hi; row += nworkers * 8) {
        const float* xr = row < MP ? p.in[0] + (size_t)row * 2048 : p.in[1] + (size_t)(row - MP) * 2048;
        float* yr = p.out + O_Y + (size_t)row * 2048;
        float ss = (lane < 32) ? OSS[(size_t)row * 32 + lane] : 0.f;
        u32x4 o[4]; f32x4 x0[4], x1[4];
#pragma unroll
        for (int i = 0; i < 4; ++i) {
            const int col = (lane + 64 * i) * 8;
            o[i] = __builtin_nontemporal_load((const u32x4*)(OB + (size_t)row * 2048 + col));
            x0[i] = __builtin_nontemporal_load((const f32x4*)(xr + col)); x1[i] = __builtin_nontemporal_load((const f32x4*)(xr + col + 4));
        }
#pragma unroll
        for (int of = 32; of >= 1; of >>= 1) ss += __shfl_xor(ss, of);
        const float rs = rsqrtf(ss * (1.0f / 2048.0f) + EPS);
#pragma unroll
        for (int i = 0; i < 4; ++i) {
            const int col = (lane + 64 * i) * 8;
            const f32x4 g0 = gA[i], g1 = gB[i];
            f32x4 y0, y1;
            y0[0] = x0[i][0] + bf_lo(o[i].x) * rs * g0[0]; y0[1] = x0[i][1] + bf_hi(o[i].x) * rs * g0[1]; y0[2] = x0[i][2] + bf_lo(o[i].y) * rs * g0[2]; y0[3] = x0[i][3] + bf_hi(o[i].y) * rs * g0[3];
            y1[0] = x1[i][0] + bf_lo(o[i].z) * rs * g1[0]; y1[1] = x1[i][1] + bf_hi(o[i].z) * rs * g1[1]; y1[2] = x1[i][2] + bf_lo(o[i].w) * rs * g1[2]; y1[3] = x1[i][3] + bf_hi(o[i].w) * rs * g1[3];
            __builtin_nontemporal_store(y0, (f32x4*)(yr + col)); __builtin_nontemporal_store(y1, (f32x4*)(yr + col + 4));
        }
    }
}

__device__ __forceinline__ void p6_final(const Params& p) {
    const int tid = threadIdx.x, lane = tid & 63, gw = (int)blockIdx.x * 8 + (tid >> 6);
    const int row = MP + (gw >> 1), half = gw & 1;
    if (row >= MT) return;
    const bf16_t* OB = (const bf16_t*)(p.ws + WS_OUTB);
    const float* OSS = (const float*)(p.ws + WS_OSS);
    const float* gpost = p.in[5];
    const float* xr = p.in[1] + (size_t)(row - MP) * 2048;
    float* yr = p.out + O_Y + (size_t)row * 2048;
    float ss = (lane < 32) ? OSS[(size_t)row * 32 + lane] : 0.f;
    u32x4 o[2]; f32x4 x0[2], x1[2], g0[2], g1[2];
#pragma unroll
    for (int i = 0; i < 2; ++i) {
        const int col = (lane + 64 * (2 * half + i)) * 8;
        o[i] = __builtin_nontemporal_load((const u32x4*)(OB + (size_t)row * 2048 + col));
        x0[i] = __builtin_nontemporal_load((const f32x4*)(xr + col)); x1[i] = __builtin_nontemporal_load((const f32x4*)(xr + col + 4));
        g0[i] = *(const f32x4*)(gpost + col); g1[i] = *(const f32x4*)(gpost + col + 4);
    }
#pragma unroll
    for (int of = 32; of >= 1; of >>= 1) ss += __shfl_xor(ss, of);
    const float rs = rsqrtf(ss * (1.0f / 2048.0f) + EPS);
#pragma unroll
    for (int i = 0; i < 2; ++i) {
        const int col = (lane + 64 * (2 * half + i)) * 8;
        f32x4 y0, y1;
        y0[0] = x0[i][0] + bf_lo(o[i].x) * rs * g0[i][0]; y0[1] = x0[i][1] + bf_hi(o[i].x) * rs * g0[i][1]; y0[2] = x0[i][2] + bf_lo(o[i].y) * rs * g0[i][2]; y0[3] = x0[i][3] + bf_hi(o[i].y) * rs * g0[i][3];
        y1[0] = x1[i][0] + bf_lo(o[i].z) * rs * g1[i][0]; y1[1] = x1[i][1] + bf_hi(o[i].z) * rs * g1[i][1]; y1[2] = x1[i][2] + bf_lo(o[i].w) * rs * g1[i][2]; y1[3] = x1[i][3] + bf_hi(o[i].w) * rs * g1[i][3];
        __builtin_nontemporal_store(y0, (f32x4*)(yr + col)); __builtin_nontemporal_store(y1, (f32x4*)(yr + col + 4));
    }
}

constexpr int LDS_BYTES = pg8::STAGE_BYTES + 16;
__global__ void __launch_bounds__(512, 2) hymba_fwd(Params p) {
    extern __shared__ __attribute__((aligned(16))) unsigned char shm[];
    LAS unsigned char* lds = (LAS unsigned char*)shm;
    const int lo = p.ph_lo, hi = p.ph_hi;
    XcdBarrier bar; bar.bar = nullptr; bar.x = 0; bar.st = nullptr;
    if (hi - lo > 1) {
        volatile LAS unsigned* st = (volatile LAS unsigned*)(lds + pg8::STAGE_BYTES);
        if (threadIdx.x == 0) { st[0] = 0u; st[1] = 0u; st[2] = 0u; }
        __syncthreads();
        bar = xcd_barrier_post((unsigned*)(p.ws + WS_BAR), st);
    }
#define IN(k) (lo <= (k) && (k) < hi)
#define SEAM(k) do { if (IN(k) && IN((k) + 1)) xcd_barrier(bar); } while (0)
    if (IN(0)) { p0_prep(p, lds); }
    SEAM(0);
    if (IN(1)) {
        pg8::Gemm g{(const bf16_t*)(p.ws + WS_ZB), (const bf16_t*)(p.ws + WS_BT1), MT, PW, 2048};
        pg8::StaticOrder S; S.init(MT, PW, (int)gridDim.x, (int)blockIdx.x);
        pg8::EpiProj E{(bf16_t*)(p.ws + WS_SEC), (float*)(p.ws + WS_VSS)};
        pg8::gemm_phase<pg8::EpiProj, pg8::StaticOrder>(lds, g, S, E);
        if (gridDim.x == 256 && blockIdx.x >= 208) {
            convert_small_weights(p, ((int)blockIdx.x - 208) * 512 + (int)threadIdx.x, 48 * 512);
            convert_weights(p, CVT_NT1, CVT_NT1 + CVT_NT2, ((int)blockIdx.x - 208) * 8 + (int)(threadIdx.x >> 6), 48 * 8);
        }
    }
    SEAM(1);
    if (IN(2)) {
        if (gridDim.x == 256) {
            const int grp = blockIdx.x >> 6, bl = blockIdx.x & 63;
            const int nL = grp == 0 ? 2 : grp == 1 ? 1 : grp == 2 ? 3 : 2, L0 = grp == 0 ? 0 : grp == 1 ? 128 : grp == 2 ? 192 : 384;
            const int nS = grp == 0 ? 3 : grp == 1 ? 4 : 1, S0 = grp == 0 ? 0 : grp == 1 ? 192 : grp == 2 ? 448 : 512;
            lru_run<LRU_FUSED ? 2 : 0>(p, lds, L0 + bl, nL, 64, 0);
            sgu_run(p, lds, S0 + bl, nS, 64);
            if (grp == 3) { __syncthreads(); lru_run<1>(p, lds, bl, 1, 0, NGRP_P); }
        } else {
            const int nu = NGRP_P * 8 + NGRP * 8 + (NGRP - NGRP_P) * 8;
            int nsgu = 0;
            for (int u = blockIdx.x; u < nu; u += gridDim.x) {
                if (u < NGRP_P * 8) { __syncthreads(); lru_run<LRU_FUSED ? 2 : 0>(p, lds, u, 1, 0, 0); }
                else if (u < NGRP_P * 8 + NGRP * 8) { const int v = u - NGRP_P * 8; __syncthreads(); sgu_run(p, lds, v, 1, 0); }
                else { const int v = u - NGRP_P * 8 - NGRP * 8; __syncthreads(); lru_run<1>(p, lds, v, 1, 0, NGRP_P); }
            }
        }
    }
    SEAM(2);
#if !LRU_FUSED
    if (IN(3)) {
        for (int u = blockIdx.x; u < NGRP_P * 8; u += gridDim.x) lru_pass2_unit(p, lds, u >> 3, u & 7);
    }
    SEAM(3);
#endif
#if N_LAUNCHES == 1
    if (IN(4) && IN(5)) {
        pg8::Gemm g{(const bf16_t*)(p.ws + WS_A2), (const bf16_t*)(p.ws + WS_BT2), MT, 2048, 2048};
        pg8::OrderG2 S{(int)blockIdx.x, bar, (LAS unsigned*)(lds + pg8::STAGE_BYTES + 8)};
        pg8::EpiOut E{(bf16_t*)(p.ws + WS_OUTB), (float*)(p.ws + WS_OSS)};
        pg8::gemm_phase<pg8::EpiOut, pg8::OrderG2>(lds, g, S, E);
        if (blockIdx.x >= 32) { xcd_barrier(bar); p5_final(p, 0, MP, (int)blockIdx.x - 32, (int)gridDim.x - 32); }
        xcd_barrier(bar);
    }
#else
#pragma unroll 1
    for (int rd = 0; rd < 2; ++rd) {
        if (IN(4 + rd)) {
            if (rd == 0 || blockIdx.x < 32 || gridDim.x <= 32) {
                pg8::Gemm g{(const bf16_t*)(p.ws + WS_A2), (const bf16_t*)(p.ws + WS_BT2), MT, 2048, 2048};
                pg8::Order2 S{rd, (int)blockIdx.x};
                pg8::EpiOut E{(bf16_t*)(p.ws + WS_OUTB), (float*)(p.ws + WS_OSS)};
                pg8::gemm_phase<pg8::EpiOut, pg8::Order2>(lds, g, S, E);
            }
            if (rd == 1 && blockIdx.x >= 32) p5_final(p, 0, MP, (int)blockIdx.x - 32, (int)gridDim.x - 32);
        }
        SEAM(4 + rd);
    }
#endif
    if (IN(6)) { if (gridDim.x == 256) p6_final(p); else p5_final(p, MP, MT, (int)blockIdx.x, (int)gridDim.x); }
#undef IN
#undef SEAM
}

extern "C" void kernel_launch(void* const* d_in, const int* in_sizes, int n_in, void* d_out, int out_size, void* d_ws, size_t ws_size, hipStream_t stream) {
    static int grid = 0;
    if (grid == 0) {
        int dev = 0, cus = 0, per_cu = 0;
        if (n_in != 18 || ws_size < WS_END) { fprintf(stderr, "kernel_launch: unexpected problem (n_in %d, ws %zu < %zu)\n", n_in, ws_size, (size_t)WS_END); grid = -1; return; }
        hipGetDevice(&dev);
        hipDeviceGetAttribute(&cus, hipDeviceAttributeMultiprocessorCount, dev);
        if (hipFuncSetAttribute((const void*)hymba_fwd, hipFuncAttributeMaxDynamicSharedMemorySize, LDS_BYTES) != hipSuccess) { fprintf(stderr, "kernel_launch: hipFuncSetAttribute failed\n"); grid = -1; return; }
        hipOccupancyMaxActiveBlocksPerMultiprocessor(&per_cu, (const void*)hymba_fwd, 512, LDS_BYTES);
        if (per_cu < 1) { fprintf(stderr, "kernel_launch: occupancy query says %d blocks per CU\n", per_cu); per_cu = 1; }
        (void)hipGetLastError();
        grid = cus;
    }
    if (grid < 0) return;
    Params p{};
    for (int i = 0; i < 18; ++i) p.in[i] = (const float*)d_in[i];
    const size_t ws_shift = (ws_size - WS_END) & ~(size_t)((2u << 20) - 1);
    p.out = (float*)d_out; p.ws = (unsigned char*)d_ws + ws_shift;
#if N_LAUNCHES == 1
    p.ph_lo = 0; p.ph_hi = 7;
    if (hipMemsetAsync((char*)p.ws + WS_BAR, 0, WS_END - WS_BAR, stream) != hipSuccess) { fprintf(stderr, "kernel_launch: memset of the barrier words / scan granules failed\n"); return; }
    hipLaunchKernelGGL(hymba_fwd, dim3(grid), dim3(512), LDS_BYTES, stream, p);
#else
#ifndef PROBE_SEQ
#define PROBE_SEQ {0, 1, 2, 3, 4, 5, 6}
#endif
    const int seq[] = PROBE_SEQ;
    for (int k : seq) {
        p.ph_lo = k; p.ph_hi = k + 1;
        hipLaunchKernelGGL(hymba_fwd, dim3(grid), dim3(512), LDS_BYTES, stream, p);
    }
#endif
}
```

```cpp
#include <hip/hip_runtime.h>
#include <cstdio>

#ifndef N_LAUNCHES
#define N_LAUNCHES 1
#endif

#ifndef LRU_FUSED
#define LRU_FUSED 1
#endif
#define LAS __attribute__((address_space(3)))
typedef unsigned short bf16_t;
typedef short bf16x8 __attribute__((ext_vector_type(8)));
typedef short s16x4 __attribute__((ext_vector_type(4)));
typedef float f32x4 __attribute__((ext_vector_type(4)));
typedef float f32x2 __attribute__((ext_vector_type(2)));
typedef unsigned u32x4 __attribute__((ext_vector_type(4)));
typedef unsigned u32x2 __attribute__((ext_vector_type(2)));

constexpr int D_MODEL = 2048, MP = 8192  , MS = 1024  , MT = MP + MS, PW = 5120, LW = 1024, SW = 1024;
constexpr int NGRP = MT / 128  , NGRP_P = MP / 128  ;
constexpr float EPS = 1e-6f;
constexpr size_t O_Y = 0, O_CONVP = (size_t)MT * D_MODEL, O_HP = O_CONVP + 4 * 3 * 1024, O_CONVS = O_HP + 4 * 1024, O_HS = O_CONVS + 128 * 3 * 1024, O_V = O_HS + 128 * 1024;
constexpr size_t WS_ZB = 0;
constexpr size_t WS_BT1 = WS_ZB + (size_t)MT * 2048 * 2;
constexpr size_t WS_BT2 = WS_BT1 + (size_t)PW * 2048 * 2;
constexpr size_t WS_SEC = WS_BT2 + (size_t)2048 * 2048 * 2;
constexpr size_t SEC_STRIDE = (size_t)MT * 1024;
constexpr size_t WS_A2 = WS_ZB;
constexpr size_t WS_OUTB = WS_SEC;
constexpr size_t WS_VSS = WS_SEC + 5 * SEC_STRIDE * 2;
constexpr size_t WS_OSS = WS_VSS + (size_t)MT * 16 * 4;
constexpr size_t WS_WRT = WS_OSS + (size_t)MT * 32 * 4;
constexpr size_t WS_WIT = WS_WRT + (size_t)8 * 128 * 128 * 2;
constexpr size_t WS_WMP = WS_WIT + (size_t)8 * 128 * 128 * 2;
constexpr size_t WS_WMS = WS_WMP + (size_t)8 * 128 * 128 * 2;
constexpr size_t WS_AB = WS_WMS + (size_t)8 * 128 * 128 * 2;
constexpr size_t WS_BAR = WS_AB + (size_t)MP * 1024 * 4;
constexpr size_t WS_AGG = WS_BAR + 16384;
constexpr size_t WS_END = WS_AGG + (size_t)64 * 8 * 128 * 8;

struct Params {
    const float* in[18];
    float* out;
    unsigned char* ws;
    int ph_lo, ph_hi;
};

__device__ __forceinline__ unsigned cvt_pk_bf16(float lo, float hi) { unsigned r; asm("v_cvt_pk_bf16_f32 %0, %1, %2" : "=v"(r) : "v"(lo), "v"(hi)); return r; }
__device__ __forceinline__ float bf_lo(unsigned w) { return __uint_as_float(w << 16); }
__device__ __forceinline__ float bf_hi(unsigned w) { return __uint_as_float(w & 0xffff0000u); }
__device__ __forceinline__ float fast_rcp(float x) { return __builtin_amdgcn_rcpf(x); }
__device__ __forceinline__ float fast_exp2(float x) { return __builtin_amdgcn_exp2f(x); }
__device__ __forceinline__ float sigmoidf_(float x) { return fast_rcp(1.0f + fast_exp2(-1.44269504f * x)); }
__device__ __forceinline__ float act_gate(float x, float ka, float kb) { return x * fast_rcp(1.0f + fast_exp2(x * (ka + kb * x * x))); }


__device__ __forceinline__ f32x2 act_gate2(f32x2 x, float ka, float kb) {
    const f32x2 y = x * (x * x * kb + ka);
    f32x2 e; e.x = fast_exp2(y.x); e.y = fast_exp2(y.y);
    const f32x2 d = e + 1.0f;
    f32x2 r; r.x = fast_rcp(d.x); r.y = fast_rcp(d.y);
    return x * r;
}
#define XB_TMO      128
#define XB_XCNT(j)  (256  + 64 * (j))
#define XB_XSUB(j)  (1280 + 64 * (j))
#define XB_XGEN(j)  (2304 + 64 * (j))
#define XB_TOP      3328
#define XB_TOPGEN   3392
#define XCD_BAR_WORDS 3456
#define XB_SPIN_CAP (1u << 18)
__device__ __forceinline__ unsigned xb_ld(unsigned* p)              { return __hip_atomic_load(p, __ATOMIC_RELAXED, __HIP_MEMORY_SCOPE_AGENT); }
__device__ __forceinline__ unsigned xb_add(unsigned* p, unsigned v) { return __hip_atomic_fetch_add(p, v, __ATOMIC_RELAXED, __HIP_MEMORY_SCOPE_AGENT); }
__device__ __forceinline__ unsigned xb_xcc_id() { return (unsigned)__builtin_amdgcn_s_getreg((3 << 11) | 20) & 0xFu; }
#define XB_SPIN(cond, bar) do { unsigned _sp = 0; while (cond) { __builtin_amdgcn_s_sleep(1); \
    if ((++_sp & 255u) == 0u) { if (xb_ld(&(bar)[XB_TMO])) break; if (_sp > XB_SPIN_CAP) { atomicAdd(&(bar)[XB_TMO], 1u); break; } } } } while (0)
struct XcdBarrier { unsigned* bar; unsigned x; volatile LAS unsigned* st; };
__device__ __forceinline__ XcdBarrier xcd_barrier_post(unsigned* bar, volatile LAS unsigned* st) {
    XcdBarrier b; b.bar = bar; b.x = xb_xcc_id(); b.st = st;
    if (threadIdx.x == 0) (void)xb_add(&bar[XB_XCNT(b.x)], 1u);
    return b;
}
__device__ __forceinline__ void xcd_barrier_complete(unsigned* bar, unsigned x, unsigned& nloc, unsigned& nx) {
    const unsigned G = gridDim.x * gridDim.y * gridDim.z;
    unsigned sum, cnt, mine, sp = 0u;
    for (;;) {
        sum = 0u; cnt = 0u; mine = 0u;
#pragma unroll
        for (unsigned j = 0; j < 16; ++j) { const unsigned c = xb_ld(&bar[XB_XCNT(j)]); sum += c; cnt += (c > 0u) ? 1u : 0u; mine = (j == x) ? c : mine; }
        if (sum == G) break;
        __builtin_amdgcn_s_sleep(1);
        if ((++sp & 255u) == 0u) { if (xb_ld(&bar[XB_TMO])) break; if (sp > XB_SPIN_CAP) { atomicAdd(&bar[XB_TMO], 1u); break; } }
    }
    nloc = mine > 0u ? mine : 1u; nx = cnt > 0u ? cnt : 1u;
}
__device__ __forceinline__ void xcd_barrier(const XcdBarrier& b) {
    asm volatile("s_waitcnt vmcnt(0)" ::: "memory");
    __syncthreads();
    if (threadIdx.x == 0) {
        unsigned* bar = b.bar;
        __builtin_amdgcn_s_waitcnt(0);
        unsigned nloc = b.st[0], nx = b.st[1];
        if (nloc == 0u) { xcd_barrier_complete(bar, b.x, nloc, nx); b.st[0] = nloc; b.st[1] = nx; }
        const unsigned old = xb_add(&bar[XB_XSUB(b.x)], 1u);
        const unsigned gen = old / nloc;
        if (old + 1u == (gen + 1u) * nloc) {
            __builtin_amdgcn_fence(__ATOMIC_RELEASE, "agent");
            asm volatile("s_waitcnt vmcnt(0)" ::: "memory");
            const unsigned og = xb_add(&bar[XB_TOP], 1u);
            const unsigned tg = og / nx;
            if (og + 1u == (tg + 1u) * nx) xb_add(&bar[XB_TOPGEN], 1u);
            else XB_SPIN(xb_ld(&bar[XB_TOPGEN]) == tg, bar);
            __builtin_amdgcn_fence(__ATOMIC_ACQUIRE, "agent");
            xb_add(&bar[XB_XGEN(b.x)], 1u);
            asm volatile("s_waitcnt vmcnt(0)" ::: "memory");
        } else {
            XB_SPIN(xb_ld(&bar[XB_XGEN(b.x)]) == gen, bar);
            __builtin_amdgcn_fence(__ATOMIC_ACQUIRE, "agent");
            asm volatile("s_waitcnt vmcnt(0)" ::: "memory");
        }
    }
    __syncthreads();
}

__device__ __forceinline__ void xcd_barrier_arrive_only(const XcdBarrier& b) {
    unsigned* bar = b.bar;
    const unsigned nloc = b.st[0], nx = b.st[1];
    const unsigned old = xb_add(&bar[XB_XSUB(b.x)], 1u);
    const unsigned gen = old / nloc;
    if (old + 1u == (gen + 1u) * nloc) {
        __builtin_amdgcn_fence(__ATOMIC_RELEASE, "agent");
        asm volatile("s_waitcnt vmcnt(0)" ::: "memory");
        const unsigned og = xb_add(&bar[XB_TOP], 1u);
        const unsigned tg = og / nx;
        if (og + 1u == (tg + 1u) * nx) xb_add(&bar[XB_TOPGEN], 1u);
        else XB_SPIN(xb_ld(&bar[XB_TOPGEN]) == tg, bar);
        __builtin_amdgcn_fence(__ATOMIC_ACQUIRE, "agent");
        xb_add(&bar[XB_XGEN(b.x)], 1u);
        asm volatile("s_waitcnt vmcnt(0)" ::: "memory");
    }
}

namespace pg8 {
constexpr int BM = 256, BK = 64, HALF = 128, HTB = HALF * BK * 2, STAGE_BYTES = 8 * HTB, NXCD = 8, WGM = 8;
__host__ __device__ __forceinline__ int lds_byte(int r, int c) { const int st = (r >> 4) * 2 + (c >> 5), rr = r & 15, cc = c & 31, ob = rr * 64 + cc * 2; return st * 1024 + (ob ^ (((ob >> 9) & 1) << 5)); }
__host__ __device__ __forceinline__ void stage_rc(int b, int& R, int& C) { const int st = b / 1024, sb = b % 1024, swz = sb ^ (((sb >> 9) & 1) << 5); R = (st >> 1) * 16 + swz / 64; C = (st & 1) * 32 + (swz % 64) / 2; }
__host__ __device__ __forceinline__ int perm32(int rho) { const int n = rho >> 4, i = rho & 15; return 8 * (i >> 2) + 4 * n + (i & 3); }
struct Unit { int pm, pn; };
struct Gemm { const bf16_t* A; const bf16_t* Bt; int M, N, K; };
struct StaticOrder {
    int nM, nN, nwg, G, c;
    __host__ __device__ void init(int M, int N, int G_, int c_) { nM = M / BM; nN = N / BM; nwg = nM * nN; G = G_; c = c_; }
    __host__ __device__ bool next(int i, Unit& u) const {
        const long L = (long)i * G + c; if (L >= nwg) return false;
        int wgid = (int)L; { const int q = nwg / NXCD, r = nwg % NXCD, xcd = wgid % NXCD, off = wgid / NXCD; wgid = (xcd < r ? xcd * (q + 1) : r * (q + 1) + (xcd - r) * q) + off; }
        const int nig = WGM * nN, gid = wgid / nig, fm = gid * WGM, gsz = (nM - fm) < WGM ? (nM - fm) : WGM;
        u.pm = fm + ((wgid % nig) % gsz); u.pn = (wgid % nig) / gsz; return true;
    }
    __device__ __forceinline__ void a_ready(const Unit&) const {}
    __device__ __forceinline__ void done(const Unit&) const {}
};

struct Order2 {
    int rd, c;
    __device__ bool next(int i, Unit& u) const {
        if (i != 0) return false;
        if (rd == 0) { const int x = c & 7, j = c >> 3; u.pm = x * 4 + (j >> 3); u.pn = j & 7; return c < 256; }
        u.pm = 32 + (c >> 3); u.pn = c & 7; return c < 32;
    }
    __device__ __forceinline__ void a_ready(const Unit&) const {}
    __device__ __forceinline__ void done(const Unit&) const {}
};
struct OrderG2 {
    int c; XcdBarrier bar; LAS unsigned* wcnt;
    __device__ bool next(int i, Unit& u) const {
        if (i == 0) { const int x = c & 7, j = c >> 3; u.pm = x * 4 + (j >> 3); u.pn = j & 7; return true; }
        if (i == 1 && c < 32) { u.pm = 32 + (c >> 3); u.pn = c & 7; return true; }
        return false;
    }
    __device__ __forceinline__ void a_ready(const Unit&) const {}
    __device__ __forceinline__ void done(const Unit& u) const {
        if (c < 32 && u.pm < 32) {
            asm volatile("s_waitcnt vmcnt(0)" ::: "memory");
            if ((threadIdx.x & 63) == 0) {
                const unsigned o = __hip_atomic_fetch_add((unsigned*)wcnt, 1u, __ATOMIC_RELAXED, __HIP_MEMORY_SCOPE_WORKGROUP);
                if (o == 7u) xcd_barrier_arrive_only(bar);
            }
        }
    }
};
struct EpiProj {
    static constexpr bool PERM = true, AFTER_DRAIN = false;
    bf16_t* sec; float* vss;
    __device__ __forceinline__ void operator()(const f32x4 (&acc)[2][2][4][2], const Unit& u, int wr, int wc, int fr, int fq) const {
        const int s = u.pn >> 2, ct = u.pn & 3;
        bf16_t* base = sec + (size_t)s * SEC_STRIDE;
        const int row0 = u.pm * BM + wr * 64 + fr, col0 = ct * 256 + wc * 32 + 8 * fq;
        const bool is_gelu = (s == 2 || s == 3);
        const float ka = is_gelu ? -2.30220819f : -1.44269504f, kb = is_gelu ? -0.10294324f : 0.0f;
#pragma unroll
        for (int ai = 0; ai < 2; ++ai)
#pragma unroll
            for (int m = 0; m < 4; ++m) {
                const int row = row0 + ai * HALF + m * 16;
                bf16_t* rowp = base + (size_t)row * 1024 + col0;
                float ss = 0.f;
#pragma unroll
                for (int bj = 0; bj < 2; ++bj) {
                    f32x4 v0 = acc[ai][bj][m][0], v1 = acc[ai][bj][m][1];
                    if (s != 0) {
#pragma unroll
                        for (int j = 0; j < 4; j += 2) { const f32x2 a = act_gate2((f32x2){v0[j], v0[j + 1]}, ka, kb), b = act_gate2((f32x2){v1[j], v1[j + 1]}, ka, kb); v0[j] = a.x; v0[j + 1] = a.y; v1[j] = b.x; v1[j + 1] = b.y; }
                    }
                    ss += (v0[0] * v0[0] + v0[1] * v0[1]) + (v0[2] * v0[2] + v0[3] * v0[3]) + (v1[0] * v1[0] + v1[1] * v1[1]) + (v1[2] * v1[2] + v1[3] * v1[3]);
                    u32x4 w; w.x = cvt_pk_bf16(v0[0], v0[1]); w.y = cvt_pk_bf16(v0[2], v0[3]); w.z = cvt_pk_bf16(v1[0], v1[1]); w.w = cvt_pk_bf16(v1[2], v1[3]);
                    *(u32x4*)(rowp + bj * HALF) = w;
                }
                if (s == 3) {
                    ss += __shfl_xor(ss, 16); ss += __shfl_xor(ss, 32);
                    if (fq == 0) vss[(size_t)row * 16 + ct * 4 + wc] = ss;
                }
            }
    }
};
struct EpiOut {
    static constexpr bool PERM = true, AFTER_DRAIN = false;
    bf16_t* O; float* oss;
    __device__ __forceinline__ void operator()(const f32x4 (&acc)[2][2][4][2], const Unit& u, int wr, int wc, int fr, int fq) const {
        const int row0 = u.pm * BM + wr * 64 + fr, col0 = u.pn * BM + wc * 32 + 8 * fq;
#pragma unroll
        for (int ai = 0; ai < 2; ++ai)
#pragma unroll
            for (int m = 0; m < 4; ++m) {
                const int row = row0 + ai * HALF + m * 16;
                bf16_t* rowp = O + (size_t)row * 2048 + col0;
                float ss = 0.f;
#pragma unroll
                for (int bj = 0; bj < 2; ++bj) {
                    const f32x4 v0 = acc[ai][bj][m][0], v1 = acc[ai][bj][m][1];
                    ss += (v0[0] * v0[0] + v0[1] * v0[1]) + (v0[2] * v0[2] + v0[3] * v0[3]) + (v1[0] * v1[0] + v1[1] * v1[1]) + (v1[2] * v1[2] + v1[3] * v1[3]);
                    u32x4 w; w.x = cvt_pk_bf16(v0[0], v0[1]); w.y = cvt_pk_bf16(v0[2], v0[3]); w.z = cvt_pk_bf16(v1[0], v1[1]); w.w = cvt_pk_bf16(v1[2], v1[3]);
                    *(u32x4*)(rowp + bj * HALF) = w;
                }
                ss += __shfl_xor(ss, 16); ss += __shfl_xor(ss, 32);
                if (fq == 0) oss[(size_t)row * 32 + u.pn * 4 + wc] = ss;
            }
    }
};

template <class Epi, class Sched>
__device__ __forceinline__ void gemm_phase(LAS unsigned char* lds, const Gemm g, const Sched& S, const Epi& E) {
    const int tid = threadIdx.x, wid = __builtin_amdgcn_readfirstlane(tid >> 6), lane = tid & 63, wr = wid >> 2, wc = wid & 3, fr = lane & 15, fq = lane >> 4;
    const int K = g.K, nt = K / BK;
    unsigned voffA[2], voffB[2];
#pragma unroll
    for (int i = 0; i < 2; ++i) { int R, C; stage_rc(tid * 16 + i * 8192, R, C); const int Rb = Epi::PERM ? ((R & ~31) + perm32(R & 31)) : R;
        voffA[i] = (unsigned)(R * K + C) * 2u; voffB[i] = (unsigned)(Rb * K + C) * 2u; }
    const size_t kstep = (size_t)(BK * 2);
    const size_t hstep = (size_t)HALF * K * 2;
    const size_t tstep = 2 * hstep;
    const unsigned ldsw = (unsigned)wid * 1024u;
    const int aoff = lds_byte(wr * 64 + fr, fq * 8), boff = lds_byte(wc * 32 + fr, fq * 8);
#define PG8_SA(b, h) (((b) * 2 + (h)) * HTB)
#define PG8_SB(b, h) ((4 + (b) * 2 + (h)) * HTB)
#define PG8_STAGE(bufoff, gbase, voff) do { _Pragma("unroll") for (int _i = 0; _i < 2; ++_i) \
        __builtin_amdgcn_global_load_lds((const unsigned*)((const char*)(gbase) + (voff)[_i]), (LAS unsigned*)(lds + (bufoff) + ldsw + _i * 8192), 16, 0, 0); } while (0)
#define PG8_LDA(dst, b, h) do { _Pragma("unroll") for (int m = 0; m < 4; ++m) _Pragma("unroll") for (int k = 0; k < 2; ++k) dst[m][k] = *(const LAS bf16x8*)(lds + PG8_SA(b, h) + aoff + m * 2048 + k * 1024); } while (0)
#define PG8_LDB(dst, b, h) do { _Pragma("unroll") for (int n = 0; n < 2; ++n) _Pragma("unroll") for (int k = 0; k < 2; ++k) dst[n][k] = *(const LAS bf16x8*)(lds + PG8_SB(b, h) + boff + n * 2048 + k * 1024); } while (0)
#define PG8_MMA(ai, bj, At, Bt) do { __builtin_amdgcn_s_setprio(1); _Pragma("unroll") for (int m = 0; m < 4; ++m) _Pragma("unroll") for (int n = 0; n < 2; ++n) _Pragma("unroll") for (int k = 0; k < 2; ++k) \
        acc[ai][bj][m][n] = __builtin_amdgcn_mfma_f32_16x16x32_bf16(Bt[n][k], At[m][k], acc[ai][bj][m][n], 0, 0, 0); __builtin_amdgcn_s_setprio(0); } while (0)
#define PG8_WAIT_V(n) asm volatile("s_waitcnt vmcnt(" #n ")" ::: "memory")
#define PG8_WAIT_L(n) asm volatile("s_waitcnt lgkmcnt(" #n ")" ::: "memory")
#define PG8_BAR __builtin_amdgcn_s_barrier()
#define PG8_SCHED __builtin_amdgcn_sched_barrier(0)
    Unit cur, nxt; int ui = 0;
    if (!S.next(0, cur)) return;
    f32x4 acc[2][2][4][2];
#pragma unroll
    for (int a = 0; a < 2; ++a)
#pragma unroll
        for (int b = 0; b < 2; ++b)
#pragma unroll
            for (int m = 0; m < 4; ++m)
#pragma unroll
                for (int n = 0; n < 2; ++n) acc[a][b][m][n] = (f32x4){0.f, 0.f, 0.f, 0.f};
    bf16x8 At[4][2], B0[2][2], B1[2][2];
    const char* cA = (const char*)g.A + (size_t)cur.pm * tstep; const char* cB = (const char*)g.Bt + (size_t)cur.pn * tstep;
    S.a_ready(cur);
    PG8_STAGE(PG8_SB(0, 0), cB, voffB); PG8_STAGE(PG8_SA(0, 0), cA, voffA); PG8_STAGE(PG8_SB(0, 1), cB + hstep, voffB); PG8_STAGE(PG8_SA(0, 1), cA + hstep, voffA);
    if (wr == 1) PG8_BAR;
    PG8_WAIT_V(4); PG8_BAR;
    PG8_STAGE(PG8_SB(1, 0), cB + kstep, voffB); PG8_STAGE(PG8_SA(1, 0), cA + kstep, voffA); PG8_STAGE(PG8_SB(1, 1), cB + hstep + kstep, voffB);
    PG8_WAIT_V(6); PG8_BAR;
    for (;;) {
        const bool has_next = S.next(ui + 1, nxt);
        const char* nA = has_next ? (const char*)g.A + (size_t)nxt.pm * tstep : cA; const char* nB = has_next ? (const char*)g.Bt + (size_t)nxt.pn * tstep : cB;
        for (int t = 0; t < nt; t += 2) {
            const bool last = (t == nt - 2);
            const char* a1 = cA + (size_t)(t + 1) * kstep;
            const char* a2 = last ? nA : cA + (size_t)(t + 2) * kstep; const char* b2 = last ? nB : cB + (size_t)(t + 2) * kstep;
            const char* a3 = a2 + kstep; const char* b3 = b2 + kstep;
            if (last && has_next) S.a_ready(nxt);
            PG8_LDB(B0, 0, 0); PG8_SCHED; PG8_LDA(At, 0, 0); PG8_STAGE(PG8_SA(1, 1), a1 + hstep, voffA);
            PG8_WAIT_L(8); PG8_BAR; PG8_WAIT_L(0); PG8_MMA(0, 0, At, B0); PG8_BAR; PG8_SCHED;
            PG8_LDB(B1, 0, 1); PG8_STAGE(PG8_SB(0, 0), b2, voffB);
            PG8_BAR; PG8_WAIT_L(0); PG8_MMA(0, 1, At, B1); PG8_BAR;
            PG8_LDA(At, 0, 1); PG8_STAGE(PG8_SA(0, 0), a2, voffA);
            PG8_BAR; PG8_WAIT_L(0); PG8_MMA(1, 0, At, B0); PG8_BAR; PG8_SCHED;
            PG8_STAGE(PG8_SB(0, 1), b2 + hstep, voffB);
            PG8_WAIT_V(6); PG8_BAR; PG8_MMA(1, 1, At, B1); PG8_BAR;
            PG8_LDB(B0, 1, 0); PG8_SCHED; PG8_LDA(At, 1, 0); PG8_STAGE(PG8_SA(0, 1), a2 + hstep, voffA);
            PG8_WAIT_L(8); PG8_BAR; PG8_WAIT_L(0); PG8_MMA(0, 0, At, B0); PG8_BAR; PG8_SCHED;
            PG8_LDB(B1, 1, 1); PG8_STAGE(PG8_SB(1, 0), b3, voffB);
            PG8_BAR; PG8_WAIT_L(0); PG8_MMA(0, 1, At, B1); PG8_BAR;
            PG8_LDA(At, 1, 1); PG8_STAGE(PG8_SA(1, 0), a3, voffA);
            PG8_BAR; PG8_WAIT_L(0); PG8_MMA(1, 0, At, B0); PG8_BAR; PG8_SCHED;
            PG8_STAGE(PG8_SB(1, 1), b3 + hstep, voffB);
            PG8_WAIT_V(6); PG8_BAR; PG8_MMA(1, 1, At, B1); PG8_BAR;
        }
        if constexpr (!Epi::AFTER_DRAIN) { E(acc, cur, wr, wc, fr, fq); S.done(cur); }
        if (!has_next) break;
#pragma unroll
        for (int a = 0; a < 2; ++a)
#pragma unroll
            for (int b = 0; b < 2; ++b)
#pragma unroll
                for (int m = 0; m < 4; ++m)
#pragma unroll
                    for (int n = 0; n < 2; ++n) acc[a][b][m][n] = (f32x4){0.f, 0.f, 0.f, 0.f};
        cur = nxt; cA = nA; cB = nB; ++ui;
    }
    PG8_WAIT_V(0);
    if (wr == 0) PG8_BAR;
    PG8_BAR;
#undef PG8_SA
#undef PG8_SB
#undef PG8_STAGE
#undef PG8_LDA
#undef PG8_LDB
#undef PG8_MMA
#undef PG8_WAIT_V
#undef PG8_WAIT_L
#undef PG8_BAR
#undef PG8_SCHED
}
}

constexpr int CVT_NT1 = 32 * 160, CVT_NT2 = 32 * 64;
__device__ __forceinline__ void convert_weights(const Params& p, int t_lo, int t_hi, int gw, int nw) {
    const int lane = threadIdx.x & 63, kg = lane & 7, nq = lane >> 3;
    unsigned char* ws = p.ws;
    for (int wt = t_lo + gw; wt < t_hi; wt += 2 * nw) {
        f32x4 v[2][8]; bf16_t* dstp[2]; bool ok[2];
#pragma unroll
        for (int u = 0; u < 2; ++u) {
            const int w_ = wt + u * nw; ok[u] = w_ < t_hi;
            const int w2 = ok[u] ? w_ : wt;
            const float* src; bf16_t* dst; int ldn, kt, nt;
            if (w2 < CVT_NT1) { src = p.in[6]; dst = (bf16_t*)(ws + WS_BT1); ldn = PW; kt = w2 / 160; nt = w2 % 160; }
            else { const int t2 = w2 - CVT_NT1; src = p.in[17]; dst = (bf16_t*)(ws + WS_BT2); ldn = 2048; kt = t2 / 64; nt = t2 % 64; }
            const int k0 = kt * 64 + 8 * kg, n = nt * 32 + 4 * nq;
            const float* sp = src + (size_t)k0 * ldn + n;
#pragma unroll
            for (int r = 0; r < 8; ++r) v[u][r] = __builtin_nontemporal_load((const f32x4*)(sp + (size_t)r * ldn));
            dstp[u] = dst + (size_t)n * 2048 + k0;
        }
#pragma unroll
        for (int u = 0; u < 2; ++u) {
            if (ok[u]) {
#pragma unroll
                for (int j = 0; j < 4; ++j) {
                    u32x4 w; w.x = cvt_pk_bf16(v[u][0][j], v[u][1][j]); w.y = cvt_pk_bf16(v[u][2][j], v[u][3][j]); w.z = cvt_pk_bf16(v[u][4][j], v[u][5][j]); w.w = cvt_pk_bf16(v[u][6][j], v[u][7][j]);
                    *(u32x4*)(dstp[u] + (size_t)j * 2048) = w;
                }
            }
        }
    }
}

__device__ __forceinline__ void convert_small_weights(const Params& p, int t0, int nt) {
    unsigned char* ws = p.ws;
    {
        const int total = 2 * 8 * 16 * 128;
        for (int idx = t0; idx < total; idx += nt) {
            const int j = idx & 127, k8 = (idx >> 7) & 15, h = (idx >> 11) & 7, which = idx >> 14;
            const float* w = (which ? p.in[11] : p.in[9]) + (size_t)h * 128 * 128;
            float f[8];
#pragma unroll
            for (int i = 0; i < 8; ++i) f[i] = w[(k8 * 8 + i) * 128 + j];
            u32x4 o; o.x = cvt_pk_bf16(f[0], f[1]); o.y = cvt_pk_bf16(f[2], f[3]); o.z = cvt_pk_bf16(f[4], f[5]); o.w = cvt_pk_bf16(f[6], f[7]);
            bf16_t* dst = (bf16_t*)(ws + (which ? WS_WIT : WS_WRT));
            *(u32x4*)(dst + ((size_t)h * 128 + j) * 128 + k8 * 8) = o;
        }
    }
    {
        const int total = 2 * 8 * 128 * 16;
        for (int idx = t0; idx < total; idx += nt) {
            const int s8 = (idx & 15) * 8, t = (idx >> 4) & 127, h = (idx >> 11) & 7, which = idx >> 14;
            const float* w = p.in[15] + (size_t)h * 128 * 128;
            float f[8];
#pragma unroll
            for (int i = 0; i < 8; ++i) {
                if (!which) f[i] = (s8 + i <= t) ? w[t * 128 + s8 + i] : 0.f;
                else f[i] = ((s8 >> 3) == (t >> 3) && i <= (t & 7)) ? w[(t & 7) * 128 + i] : 0.f;
            }
            u32x4 o; o.x = cvt_pk_bf16(f[0], f[1]); o.y = cvt_pk_bf16(f[2], f[3]); o.z = cvt_pk_bf16(f[4], f[5]); o.w = cvt_pk_bf16(f[6], f[7]);
            bf16_t* dst = (bf16_t*)(ws + (which ? WS_WMS : WS_WMP));
            *(u32x4*)(dst + ((size_t)h * 128 + t) * 128 + s8) = o;
        }
    }
}

__device__ __forceinline__ void p0_prep(const Params& p, LAS unsigned char* lds) {
    const int tid = threadIdx.x, lane = tid & 63, wid = tid >> 6;
    unsigned char* ws = p.ws;
    convert_weights(p, 0, (gridDim.x == 256) ? CVT_NT1 : CVT_NT1 + CVT_NT2, blockIdx.x * 8 + wid, gridDim.x * 8);
    if (gridDim.x != 256) convert_small_weights(p, blockIdx.x * 512 + tid, gridDim.x * 512);
    {
        bf16_t* zb = (bf16_t*)(ws + WS_ZB);
        const float* gpre = p.in[4];
        f32x4 gg[8];
#pragma unroll
        for (int i = 0; i < 8; ++i) gg[i] = *(const f32x4*)(gpre + (lane + 64 * i) * 4);
        for (int row = blockIdx.x * 8 + wid; row < MT; row += gridDim.x * 8) {
            const float* xr = row < MP ? p.in[0] + (size_t)row * 2048 : p.in[1] + (size_t)(row - MP) * 2048;
            f32x4 v[8]; float ss = 0.f;
#pragma unroll
            for (int i = 0; i < 8; ++i) { v[i] = __builtin_nontemporal_load((const f32x4*)(xr + (lane + 64 * i) * 4)); ss += (v[i][0] * v[i][0] + v[i][1] * v[i][1]) + (v[i][2] * v[i][2] + v[i][3] * v[i][3]); }
#pragma unroll
            for (int o = 32; o >= 1; o >>= 1) ss += __shfl_xor(ss, o);
            const float rs = rsqrtf(ss * (1.0f / 2048.0f) + EPS);
#pragma unroll
            for (int i = 0; i < 8; ++i) {
                u32x2 w; w.x = cvt_pk_bf16(v[i][0] * rs * gg[i][0], v[i][1] * rs * gg[i][1]); w.y = cvt_pk_bf16(v[i][2] * rs * gg[i][2], v[i][3] * rs * gg[i][3]);
                *(u32x2*)(zb + (size_t)row * 2048 + (lane + 64 * i) * 4) = w;
            }
        }
    }
}

constexpr int XCB_LD = 136, XCF_LD = 132, XCF_OFF = 128 * XCB_LD * 2, HIN_OFF = XCF_OFF + 128 * XCF_LD * 4, CW_OFF = HIN_OFF + 512;
__device__ __forceinline__ void unpack8(const u32x4 w, float (&f)[8]) { f[0] = bf_lo(w.x); f[1] = bf_hi(w.x); f[2] = bf_lo(w.y); f[3] = bf_hi(w.y); f[4] = bf_lo(w.z); f[5] = bf_hi(w.z); f[6] = bf_lo(w.w); f[7] = bf_hi(w.w); }
struct LruIn { u32x4 xw[7]; };
template <int MODE>
__device__ __forceinline__ void lru_load(const Params& p, int g, int h, LruIn& R) {
    int tid_ = threadIdx.x; asm volatile("" : "+v"(tid_));
    const int tid = tid_, lane = tid & 63, wid = __builtin_amdgcn_readfirstlane(tid >> 6), fr = lane & 15, fq = lane >> 4;
    unsigned char* ws = p.ws;
    const bf16_t* XR = (const bf16_t*)(ws + WS_SEC);
    const bf16_t* SGR = XR + SEC_STRIDE;
    const int row0 = g * 128, ch0 = h * 128;
    constexpr bool samp = (MODE == 1), fused = (MODE == 2);
    const int c = g & 15, ns0 = (g - NGRP_P) * 16;
    const int rg = tid >> 4, c8 = (tid & 15) * 8, chl = 16 * wid + fr;
#pragma unroll
    for (int k = 0; k < 7; ++k) {
        const int rr = 4 * rg + k - 3;
        if (samp && k < 3 && (rg & 1) == 0) {
            const float* st = p.in[2] + ((size_t)(ns0 + (rg >> 1)) * 3 + k) * 1024 + ch0 + c8;
            const f32x4 a = *(const f32x4*)st, b = *(const f32x4*)(st + 4);
            R.xw[k].x = cvt_pk_bf16(a[0], a[1]); R.xw[k].y = cvt_pk_bf16(a[2], a[3]); R.xw[k].z = cvt_pk_bf16(b[0], b[1]); R.xw[k].w = cvt_pk_bf16(b[2], b[3]);
        } else if (samp || c * 128 + rr >= 0) {
            R.xw[k] = __builtin_nontemporal_load((const u32x4*)(XR + (size_t)(row0 + rr) * 1024 + ch0 + c8));
        } else R.xw[k] = (u32x4){0u, 0u, 0u, 0u};
    }
}
template <int MODE>
__device__ __forceinline__ void lru_unit(const Params& p, LAS unsigned char* lds, int g, int h, LruIn& IN, bool pf_next, int gn, int hn, LruIn& NX, const float c_r, const float c_i, const float spl) {
    int tid_ = threadIdx.x; asm volatile("" : "+v"(tid_));
    const int tid = tid_, lane = tid & 63, wid = __builtin_amdgcn_readfirstlane(tid >> 6), fr = lane & 15, fq = lane >> 4;
    unsigned char* ws = p.ws;
    const bf16_t* XR = (const bf16_t*)(ws + WS_SEC);
    const bf16_t* SGR = XR + SEC_STRIDE;
    bf16_t* A2 = (bf16_t*)(ws + WS_A2);
    float* AGG = (float*)(ws + WS_AGG);
    unsigned* AB = (unsigned*)(ws + WS_AB);
    LAS bf16_t* XCB = (LAS bf16_t*)lds;
    LAS float* XCF = (LAS float*)(lds + XCF_OFF);
    const int row0 = g * 128, ch0 = h * 128;
    constexpr bool samp = (MODE == 1), fused = (MODE == 2);
    const int c = g & 15, nseq = g >> 4;
    const int ns0 = (g - NGRP_P) * 16;
    const int rg = tid >> 4, c8 = (tid & 15) * 8;
    const int lrow0 = 16 * (rg & 7) + 4 * (rg >> 3);
    const int chl = 16 * wid + fr, ch = ch0 + chl;
    bf16x8 br[4], bi[4];
    {
        const bf16_t* WRT = (const bf16_t*)(ws + WS_WRT) + ((size_t)h * 128 + chl) * 128 + 8 * fq;
        const bf16_t* WIT = (const bf16_t*)(ws + WS_WIT) + ((size_t)h * 128 + chl) * 128 + 8 * fq;
#pragma unroll
        for (int ks = 0; ks < 4; ++ks) { br[ks] = *(const bf16x8*)(WRT + 32 * ks); bi[ks] = *(const bf16x8*)(WIT + 32 * ks); }
    }
    float h0v[4];
    u32x4 sgrk[4];
    if (samp || fused) {
#pragma unroll
        for (int i = 0; i < 4; ++i) sgrk[i] = __builtin_nontemporal_load((const u32x4*)(SGR + (size_t)(row0 + 4 * rg + i) * 1024 + ch0 + c8));
    }
    if (samp) {
#pragma unroll
        for (int k = 0; k < 4; ++k) h0v[k] = p.in[3][(size_t)(ns0 + 4 * fq + k) * 1024 + ch];
    }
    {
        {
            const bool tail = samp ? ((rg & 1) != 0) : (c == 15 && rg == 31);
            if (tail) {
                float* dst = samp ? p.out + O_CONVS + ((size_t)(ns0 + (rg >> 1)) * 3) * 1024 + ch0 + c8 : p.out + O_CONVP + ((size_t)nseq * 3) * 1024 + ch0 + c8;
#pragma unroll
                for (int k = 4; k < 7; ++k) { float f[8]; unpack8(IN.xw[k], f); *(f32x4*)(dst + (k - 4) * 1024) = (f32x4){f[0], f[1], f[2], f[3]}; *(f32x4*)(dst + (k - 4) * 1024 + 4) = (f32x4){f[4], f[5], f[6], f[7]}; }
            }
        }
        float acc[4][8];
        {
            const LAS float* CWL = (const LAS float*)(lds + CW_OFF);
            const f32x4 a = *(const LAS f32x4*)(CWL + c8), b = *(const LAS f32x4*)(CWL + c8 + 4);
#pragma unroll
            for (int i = 0; i < 4; ++i) { acc[i][0] = a[0]; acc[i][1] = a[1]; acc[i][2] = a[2]; acc[i][3] = a[3]; acc[i][4] = b[0]; acc[i][5] = b[1]; acc[i][6] = b[2]; acc[i][7] = b[3]; }
        }
#pragma unroll
        for (int kw = 0; kw < 4; ++kw) {
            const LAS float* CWL = (const LAS float*)(lds + CW_OFF) + 128 * (kw + 1);
            const f32x4 a = *(const LAS f32x4*)(CWL + c8), b = *(const LAS f32x4*)(CWL + c8 + 4);
            const float cw[8] = {a[0], a[1], a[2], a[3], b[0], b[1], b[2], b[3]};
#pragma unroll
            for (int i = 0; i < 4; ++i) { float f[8]; unpack8(IN.xw[i + kw], f);
#pragma unroll
                for (int e = 0; e < 8; ++e) acc[i][e] += cw[e] * f[e]; }
        }
#pragma unroll
        for (int i = 0; i < 4; ++i) {
            const int r = lrow0 + i;
            u32x4 w; w.x = cvt_pk_bf16(acc[i][0], acc[i][1]); w.y = cvt_pk_bf16(acc[i][2], acc[i][3]); w.z = cvt_pk_bf16(acc[i][4], acc[i][5]); w.w = cvt_pk_bf16(acc[i][6], acc[i][7]);
            *(LAS u32x4*)(XCB + r * XCB_LD + c8) = w;
        }
    }
    __syncthreads();
    f32x4 ar[8], ai[8];
#pragma unroll
    for (int m = 0; m < 8; ++m) { ar[m] = (f32x4){0.f, 0.f, 0.f, 0.f}; ai[m] = (f32x4){0.f, 0.f, 0.f, 0.f}; }
#pragma unroll
    for (int m = 0; m < 8; ++m)
#pragma unroll
        for (int ks = 0; ks < 4; ++ks) {
            const bf16x8 a = *(const LAS bf16x8*)(XCB + (16 * m + fr) * XCB_LD + 32 * ks + 8 * fq);
            ar[m] = __builtin_amdgcn_mfma_f32_16x16x32_bf16(a, br[ks], ar[m], 0, 0, 0);
            ai[m] = __builtin_amdgcn_mfma_f32_16x16x32_bf16(a, bi[ks], ai[m], 0, 0, 0);
        }
    constexpr float L2E = 1.44269504f;
    float A = 1.f, B = 0.f;
#pragma unroll
    for (int m = 0; m < 8; ++m) {
#pragma unroll
        for (int jp = 0; jp < 4; jp += 2) {
            const f32x2 zr = (f32x2){ar[m][jp], ar[m][jp + 1]} * (-L2E) + c_r, zi = (f32x2){ai[m][jp], ai[m][jp + 1]} * (-L2E) + c_i;
            f32x2 er, ei; er.x = fast_exp2(zr.x); er.y = fast_exp2(zr.y); ei.x = fast_exp2(zi.x); ei.y = fast_exp2(zi.y);
            const f32x2 dr = er + 1.0f, di = ei + 1.0f;
            f32x2 rr, ii; rr.x = fast_rcp(dr.x); rr.y = fast_rcp(dr.y); ii.x = fast_rcp(di.x); ii.y = fast_rcp(di.y);
            f32x2 la = rr * spl;
            f32x2 a; a.x = fast_exp2(la.x); a.y = fast_exp2(la.y);
            const f32x2 om = 1.0f - a * a;
            f32x2 mult; mult.x = __builtin_amdgcn_sqrtf(om.x); mult.y = __builtin_amdgcn_sqrtf(om.y);
            const f32x2 xc = (f32x2){__uint_as_float((unsigned)XCB[(16 * m + 4 * fq + jp) * XCB_LD + chl] << 16), __uint_as_float((unsigned)XCB[(16 * m + 4 * fq + jp + 1) * XCB_LD + chl] << 16)};
            if (!samp && m == 0 && jp == 0) { if (c == 0 && fq == 0) { a.x = 0.f; mult.x = 1.f; la.x = -INFINITY; } }
            f32x2 b = mult * ii * xc;
            if (samp && jp == 0 && (m & 1) == 0) { b.x += a.x * h0v[m >> 1]; a.x = 0.f; }
            B = a.x * B + b.x; A = a.x * A;
            if (MODE == 0) AB[(size_t)(row0 + 32 * fq + 4 * m + jp) * 1024 + ch] = cvt_pk_bf16(la.x, b.x);
            else { ar[m][jp] = A; ai[m][jp] = B; }
            B = a.y * B + b.y; A = a.y * A;
            if (MODE == 0) AB[(size_t)(row0 + 32 * fq + 4 * m + jp + 1) * 1024 + ch] = cvt_pk_bf16(la.y, b.y);
            else { ar[m][jp + 1] = A; ai[m][jp + 1] = B; }
        }
    }
    if (pf_next) lru_load<MODE>(p, gn, hn, NX);
    if (MODE == 0) {
        float Ai = A, Bi = B;
        { const float sa = __shfl_up(Ai, 16), sb = __shfl_up(Bi, 16); if (fq >= 1) { Bi = Ai * sb + Bi; Ai = sa * Ai; } }
        { const float sa = __shfl_up(Ai, 32), sb = __shfl_up(Bi, 32); if (fq >= 2) { Bi = Ai * sb + Bi; Ai = sa * Ai; } }
        if (fq == 3) { float* a = AGG + ((size_t)(g * 8 + h)) * 256 + chl; a[0] = Ai; a[128] = Bi; }
        __syncthreads();
        return;
    }
    if (fused) {
        float Ai = A, Bi = B;
        { const float sa = __shfl_up(Ai, 16), sb = __shfl_up(Bi, 16); if (fq >= 1) { Bi = Ai * sb + Bi; Ai = sa * Ai; } }
        { const float sa = __shfl_up(Ai, 32), sb = __shfl_up(Bi, 32); if (fq >= 2) { Bi = Ai * sb + Bi; Ai = sa * Ai; } }
        float ea = __shfl_up(Ai, 16), eb = __shfl_up(Bi, 16); if (fq == 0) { ea = 1.f; eb = 0.f; }
        unsigned long long* GR = (unsigned long long*)(ws + WS_AGG);
        if (fq == 3) __hip_atomic_store(GR + ((size_t)(g * 8 + h)) * 128 + chl, ((unsigned long long)__float_as_uint(Bi) << 32) | (unsigned long long)(__float_as_uint(Ai) | 0x80000000u), __ATOMIC_RELAXED, __HIP_MEMORY_SCOPE_AGENT);
        if (tid < 128 && c > 0) {
            const unsigned long long* gp = GR + ((size_t)(nseq * 16) * 8 + h) * 128 + tid;
            unsigned long long gv[15]; unsigned polls = 0;
            for (;;) {
                bool ok = true;
#pragma unroll
                for (int cc = 0; cc < 15; ++cc) { const int ci = cc < c ? cc : 0; gv[cc] = __hip_atomic_load(gp + (size_t)ci * 1024, __ATOMIC_RELAXED, __HIP_MEMORY_SCOPE_AGENT); }
#pragma unroll
                for (int cc = 0; cc < 15; ++cc) ok = ok && ((int)(unsigned)gv[cc] < 0);
                if (__all(ok) || ++polls > (1u << 18)) break;
                __builtin_amdgcn_s_sleep(1);
            }
            float Hc = 0.f;
#pragma unroll
            for (int cc = 0; cc < 15; ++cc) Hc = (cc < c) ? __uint_as_float((unsigned)(gv[cc] >> 32)) + __uint_as_float((unsigned)gv[cc] & 0x7fffffffu) * Hc : Hc;
            ((LAS float*)(lds + HIN_OFF))[tid] = Hc;
        }
        __syncthreads();
        const float Hin = c > 0 ? ((LAS float*)(lds + HIN_OFF))[chl] : 0.f;
        const float hs = eb + ea * Hin;
#pragma unroll
        for (int m = 0; m < 8; ++m)
#pragma unroll
            for (int j = 0; j < 4; ++j) ai[m][j] = ai[m][j] + ar[m][j] * hs;
    }
#pragma unroll
    for (int m = 0; m < 8; ++m)
#pragma unroll
        for (int j = 0; j < 4; ++j) XCF[(16 * m + 4 * fq + j) * XCF_LD + chl] = ai[m][j];
    __syncthreads();
    {
#pragma unroll
        for (int i = 0; i < 4; ++i) {
            const int r = 4 * rg + i, lr = lrow0 + i;
            const f32x4 h0 = *(const LAS f32x4*)(XCF + lr * XCF_LD + c8), h1 = *(const LAS f32x4*)(XCF + lr * XCF_LD + c8 + 4);
            const u32x4 gw = sgrk[i];
            u32x4 w; w.x = cvt_pk_bf16(h0[0] * bf_lo(gw.x), h0[1] * bf_hi(gw.x)); w.y = cvt_pk_bf16(h0[2] * bf_lo(gw.y), h0[3] * bf_hi(gw.y));
            w.z = cvt_pk_bf16(h1[0] * bf_lo(gw.z), h1[1] * bf_hi(gw.z)); w.w = cvt_pk_bf16(h1[2] * bf_lo(gw.w), h1[3] * bf_hi(gw.w));
            *(u32x4*)(A2 + (size_t)(row0 + r) * 2048 + ch0 + c8) = w;
            if (samp) { if (i == 3 && (rg & 1) != 0) { float* dst = p.out + O_HS + (size_t)(ns0 + (rg >> 1)) * 1024 + ch0 + c8; *(f32x4*)dst = h0; *(f32x4*)(dst + 4) = h1; } }
            else { if (i == 3 && c == 15 && rg == 31) { float* dst = p.out + O_HP + (size_t)nseq * 1024 + ch0 + c8; *(f32x4*)dst = h0; *(f32x4*)(dst + 4) = h1; } }
        }
    }
    __syncthreads();
}

template <int MODE>
__device__ __forceinline__ void lru_run(const Params& p, LAS unsigned char* lds, int first, int count, int stride, int gofs) {
    LruIn La, Lb;
    const int u0 = first, u1 = first + stride, u2 = first + 2 * stride;
    lru_load<MODE>(p, gofs + (u0 >> 3), u0 & 7, La);
    if (threadIdx.x < 160) {
        const int k = threadIdx.x >> 5, c4 = (threadIdx.x & 31) * 4;
        const float* src = (k == 0 ? p.in[8] : p.in[7] + (k - 1) * 1024) + (u0 & 7) * 128 + c4;
        *(LAS f32x4*)((LAS float*)(lds + CW_OFF) + 128 * k + c4) = *(const f32x4*)src;
    }
    __syncthreads();
    constexpr float L2E = 1.44269504f;
    const int chn = (u0 & 7) * 128 + 16 * (int)(threadIdx.x >> 6) + (int)(threadIdx.x & 15);
    const float c_r = -L2E * p.in[10][chn], c_i = -L2E * p.in[12][chn];
    float spl;
    { const float nl = -p.in[13][chn]; spl = -8.0f * L2E * (fmaxf(nl, 0.f) + log1pf(__expf(-fabsf(nl)))); }
    lru_unit<MODE>(p, lds, gofs + (u0 >> 3), u0 & 7, La, count > 1, gofs + (u1 >> 3), u1 & 7, Lb, c_r, c_i, spl);
    if (count > 1) {
        lru_unit<MODE>(p, lds, gofs + (u1 >> 3), u1 & 7, Lb, count > 2, gofs + (u2 >> 3), u2 & 7, La, c_r, c_i, spl);
        if (count > 2) lru_unit<MODE>(p, lds, gofs + (u2 >> 3), u2 & 7, La, false, 0, 0, Lb, c_r, c_i, spl);
    }
}

__device__ __forceinline__ void lru_pass2_unit(const Params& p, LAS unsigned char* lds, int g, int h) {
    int tid_ = threadIdx.x; asm volatile("" : "+v"(tid_));
    const int tid = tid_, q = __builtin_amdgcn_readfirstlane(tid >> 6), cp = (tid & 63) * 2;
    unsigned char* ws = p.ws;
    const bf16_t* SGR = (const bf16_t*)(ws + WS_SEC) + SEC_STRIDE;
    bf16_t* A2 = (bf16_t*)(ws + WS_A2);
    const float* AGG = (const float*)(ws + WS_AGG);
    const unsigned* AB = (const unsigned*)(ws + WS_AB);
    LAS float* HIN = (LAS float*)lds;
    LAS float* TOT = (LAS float*)(lds + 512);
    const int row0 = g * 128, ch0 = h * 128, c = g & 15, nseq = g >> 4;
    u32x2 ab[16]; unsigned sg[16];
#pragma unroll
    for (int r = 0; r < 16; ++r) {
        ab[r] = __builtin_nontemporal_load((const u32x2*)(AB + (size_t)(row0 + 16 * q + r) * 1024 + ch0 + cp));
        sg[r] = __builtin_nontemporal_load((const unsigned*)(SGR + (size_t)(row0 + 16 * q + r) * 1024 + ch0 + cp));
    }
    if (tid < 128) {
        const float* a = AGG + ((size_t)(nseq * 16) * 8 + h) * 256 + tid;
        float H = 0.f;
#pragma unroll
        for (int c0 = 0; c0 < 15; c0 += 5) {
            float Pv[5], Bv[5];
#pragma unroll
            for (int cc = 0; cc < 5; ++cc) { const int ci = (c0 + cc) < c ? (c0 + cc) : 0; Pv[cc] = a[(size_t)ci * 2048]; Bv[cc] = a[(size_t)ci * 2048 + 128]; }
#pragma unroll
            for (int cc = 0; cc < 5; ++cc) H = ((c0 + cc) < c) ? Bv[cc] + Pv[cc] * H : H;
        }
        HIN[tid] = H;
    }
    float av0[16], av1[16];
    float A0 = 1.f, B0 = 0.f, A1 = 1.f, B1 = 0.f;
#pragma unroll
    for (int r = 0; r < 16; ++r) {
        av0[r] = fast_exp2(bf_lo(ab[r].x)); av1[r] = fast_exp2(bf_lo(ab[r].y));
        B0 = av0[r] * B0 + bf_hi(ab[r].x); A0 *= av0[r];
        B1 = av1[r] * B1 + bf_hi(ab[r].y); A1 *= av1[r];
    }
    TOT[(q * 2 + 0) * 128 + cp] = A0; TOT[(q * 2 + 0) * 128 + cp + 1] = A1;
    TOT[(q * 2 + 1) * 128 + cp] = B0; TOT[(q * 2 + 1) * 128 + cp + 1] = B1;
    __syncthreads();
    float H0 = HIN[cp], H1 = HIN[cp + 1];
    for (int qq = 0; qq < q; ++qq) {
        H0 = TOT[(qq * 2 + 1) * 128 + cp] + TOT[(qq * 2 + 0) * 128 + cp] * H0;
        H1 = TOT[(qq * 2 + 1) * 128 + cp + 1] + TOT[(qq * 2 + 0) * 128 + cp + 1] * H1;
    }
#pragma unroll
    for (int r = 0; r < 16; ++r) {
        H0 = av0[r] * H0 + bf_hi(ab[r].x); H1 = av1[r] * H1 + bf_hi(ab[r].y);
        *(unsigned*)(A2 + (size_t)(row0 + 16 * q + r) * 2048 + ch0 + cp) = cvt_pk_bf16(H0 * bf_lo(sg[r]), H1 * bf_hi(sg[r]));
    }
    if (c == 15 && q == 7) { *(f32x2*)(p.out + O_HP + (size_t)nseq * 1024 + ch0 + cp) = (f32x2){H0, H1}; }
    __syncthreads();
}


struct SguRegs { bf16x8 wfrag[4]; u32x4 gu[4], sg[4]; float bias; u32x4 gv[4]; float q[4]; f32x4 g0, g1; };
template <bool EARLY, bool LATE>
__device__ __forceinline__ void sgu_stage1a(const Params& p, int g, int h, SguRegs& R) {
    int tid_ = threadIdx.x; asm volatile("" : "+v"(tid_));
    const int tid = tid_, lane = tid & 63, wid = __builtin_amdgcn_readfirstlane(tid >> 6), fr = lane & 15, fq = lane >> 4;
    unsigned char* ws = p.ws;
    const bf16_t* GU = (const bf16_t*)(ws + WS_SEC) + 2 * SEC_STRIDE;
    const bf16_t* GV = GU + SEC_STRIDE;
    const bf16_t* SGS = GV + SEC_STRIDE;
    const float* VSS = (const float*)(ws + WS_VSS);
    const int row0 = g * 128, d0 = h * 128;
    const bool samp = g >= NGRP_P;
    const int d8 = (tid & 15) * 8, sb = tid >> 4;
    if (EARLY) {
#pragma unroll
        for (int it = 0; it < 4; ++it) R.gv[it] = __builtin_nontemporal_load((const u32x4*)(GV + (size_t)(row0 + sb + 32 * it) * 1024 + d0 + d8));
#pragma unroll
        for (int it = 0; it < 4; ++it) R.q[it] = VSS[(size_t)(row0 + sb + 32 * it) * 16 + (tid & 15)];
        R.g0 = *(const f32x4*)(p.in[14] + d0 + d8); R.g1 = *(const f32x4*)(p.in[14] + d0 + d8 + 4);
    }
    if (LATE) {
        const bf16_t* WM = (const bf16_t*)(ws + (samp ? WS_WMS : WS_WMP)) + ((size_t)h * 128 + 16 * wid + fr) * 128 + 8 * fq;
#pragma unroll
        for (int ks = 0; ks < 4; ++ks) R.wfrag[ks] = *(const bf16x8*)(WM + 32 * ks);
        const int t = 16 * wid + fr, row = row0 + t;
#pragma unroll
        for (int k = 0; k < 4; ++k) { const int col = d0 + 32 * k + 8 * fq; R.gu[k] = __builtin_nontemporal_load((const u32x4*)(GU + (size_t)row * 1024 + col)); R.sg[k] = __builtin_nontemporal_load((const u32x4*)(SGS + (size_t)row * 1024 + col)); }
        R.bias = p.in[16][h * 128 + (samp ? (t & 7) : t)];
    }
}
__device__ __forceinline__ void sgu_stage1b(const Params& p, LAS unsigned char* lds, int g, int h, int vt_off, SguRegs& R) {
    int tid_ = threadIdx.x; asm volatile("" : "+v"(tid_));
    const int tid = tid_;
    LAS bf16_t* VT = (LAS bf16_t*)(lds + vt_off);
    const int row0 = g * 128, d0 = h * 128;
    const bool samp = g >= NGRP_P;
    const int d8 = (tid & 15) * 8, sb = tid >> 4;
    float rsv[4];
#pragma unroll
    for (int it = 0; it < 4; ++it) {
        float q = R.q[it];
        q += __shfl_xor(q, 1); q += __shfl_xor(q, 2); q += __shfl_xor(q, 4); q += __shfl_xor(q, 8);
        rsv[it] = rsqrtf(q * (1.0f / 1024.0f) + EPS);
    }
    const float gg[8] = {R.g0[0], R.g0[1], R.g0[2], R.g0[3], R.g1[0], R.g1[1], R.g1[2], R.g1[3]};
#pragma unroll
    for (int it = 0; it < 4; ++it) {
        const int s = sb + 32 * it;
        const float rs = rsv[it];
        float f[8]; unpack8(R.gv[it], f);
#pragma unroll
        for (int i = 0; i < 8; ++i) f[i] = f[i] * rs * gg[i];
        if (samp) {
            float* dst = p.out + O_V + (size_t)(row0 - MP + s) * 1024 + d0 + d8;
            *(f32x4*)dst = (f32x4){f[0], f[1], f[2], f[3]}; *(f32x4*)(dst + 4) = (f32x4){f[4], f[5], f[6], f[7]};
        }
        u32x4 w; w.x = cvt_pk_bf16(f[0], f[1]); w.y = cvt_pk_bf16(f[2], f[3]); w.z = cvt_pk_bf16(f[4], f[5]); w.w = cvt_pk_bf16(f[6], f[7]);
        *(LAS u32x4*)((LAS unsigned char*)VT + 256 * s + 16 * ((tid & 15) ^ (((s & 3) << 2) | ((s >> 2) & 3)))) = w;
    }
}
__device__ __forceinline__ void sgu_stage2(const Params& p, LAS unsigned char* lds, int g, int h, int vt_off, const SguRegs& R) {
    int tid_ = threadIdx.x; asm volatile("" : "+v"(tid_));
    const int tid = tid_, lane = tid & 63, wid = __builtin_amdgcn_readfirstlane(tid >> 6), fr = lane & 15, fq = lane >> 4;
    bf16_t* A2 = (bf16_t*)(p.ws + WS_A2);
    LAS bf16_t* VT = (LAS bf16_t*)(lds + vt_off);
    const int row = g * 128 + 16 * wid + fr, d0 = h * 128;
    f32x4 acc[8];
#pragma unroll
    for (int n = 0; n < 8; ++n) acc[n] = (f32x4){0.f, 0.f, 0.f, 0.f};
    const int ksmax = wid >> 1;
    int frv = fr; asm volatile("" : "+v"(frv));
#pragma unroll
    for (int ks = 0; ks < 4; ++ks) {
        if (ks <= ksmax) {
#pragma unroll
            for (int n = 0; n < 8; ++n) {
                bf16x8 vfrag;
#pragma unroll
                for (int t2 = 0; t2 < 2; ++t2) {
                    const int row = 32 * ks + 8 * fq + 4 * t2 + (frv >> 2);
                    const int ch = (4 * (n >> 1) + (frv & 3)) ^ (((row & 3) << 2) | ((row >> 2) & 3));
                    const s16x4 h = __builtin_amdgcn_ds_read_tr16_b64_v4i16((LAS s16x4*)((LAS unsigned char*)VT + 256 * row + 16 * ch + 8 * (n & 1)));
                    vfrag[4 * t2 + 0] = h[0]; vfrag[4 * t2 + 1] = h[1]; vfrag[4 * t2 + 2] = h[2]; vfrag[4 * t2 + 3] = h[3];
                }
                acc[n] = __builtin_amdgcn_mfma_f32_16x16x32_bf16(vfrag, R.wfrag[ks], acc[n], 0, 0, 0);
            }
        }
    }
    const float bias = R.bias;
#pragma unroll
    for (int k = 0; k < 4; ++k) {
        const int col = d0 + 32 * k + 8 * fq;
        const f32x4 a0 = acc[2 * k], a1 = acc[2 * k + 1];
        u32x4 w;
        w.x = cvt_pk_bf16((a0[0] + bias) * bf_lo(R.gu[k].x) * bf_lo(R.sg[k].x), (a0[1] + bias) * bf_hi(R.gu[k].x) * bf_hi(R.sg[k].x));
        w.y = cvt_pk_bf16((a0[2] + bias) * bf_lo(R.gu[k].y) * bf_lo(R.sg[k].y), (a0[3] + bias) * bf_hi(R.gu[k].y) * bf_hi(R.sg[k].y));
        w.z = cvt_pk_bf16((a1[0] + bias) * bf_lo(R.gu[k].z) * bf_lo(R.sg[k].z), (a1[1] + bias) * bf_hi(R.gu[k].z) * bf_hi(R.sg[k].z));
        w.w = cvt_pk_bf16((a1[2] + bias) * bf_lo(R.gu[k].w) * bf_lo(R.sg[k].w), (a1[3] + bias) * bf_hi(R.gu[k].w) * bf_hi(R.sg[k].w));
        *(u32x4*)(A2 + (size_t)row * 2048 + 1024 + col) = w;
    }
}
__device__ __forceinline__ void sgu_run(const Params& p, LAS unsigned char* lds, int first, int count, int stride) {
    SguRegs Ra, Rb;
    if (count <= 0) return;
    sgu_stage1a<true, true>(p, first >> 3, first & 7, Ra);
#pragma unroll 1
    for (int k = 0; k < count; k += 2) {
        const int u0 = first + k * stride, u1 = u0 + stride;
        const bool has1 = (k + 1) < count, has2 = (k + 2) < count;
        if (has1) sgu_stage1a<true, true>(p, u1 >> 3, u1 & 7, Rb);
        sgu_stage1b(p, lds, u0 >> 3, u0 & 7, 0, Ra);
        __syncthreads();
        sgu_stage2(p, lds, u0 >> 3, u0 & 7, 0, Ra);
        if (!has1) break;
        if (has2) { const int u2 = u1 + stride; sgu_stage1a<true, true>(p, u2 >> 3, u2 & 7, Ra); }
        sgu_stage1b(p, lds, u1 >> 3, u1 & 7, 34816, Rb);
        __syncthreads();
        sgu_stage2(p, lds, u1 >> 3, u1 & 7, 34816, Rb);
    }
}


__device__ __forceinline__ void p5_final(const Params& p, int row_lo, int row_hi, int worker, int nworkers) {
    const int tid = threadIdx.x, lane = tid & 63, wid = tid >> 6;
    const bf16_t* OB = (const bf16_t*)(p.ws + WS_OUTB);
    const float* OSS = (const float*)(p.ws + WS_OSS);
    const float* gpost = p.in[5];
    f32x4 gA[4], gB[4];
#pragma unroll
    for (int i = 0; i < 4; ++i) { const int col = (lane + 64 * i) * 8; gA[i] = *(const f32x4*)(gpost + col); gB[i] = *(const f32x4*)(gpost + col + 4); }
    for (int row = row_lo + worker * 8 + wid; row < row_hi; row += nworkers * 8) {
        const float* xr = row < MP ? p.in[0] + (size_t)row * 2048 : p.in[1] + (size_t)(row - MP) * 2048;
        float* yr = p.out + O_Y + (size_t)row * 2048;
        float ss = (lane < 32) ? OSS[(size_t)row * 32 + lane] : 0.f;
        u32x4 o[4]; f32x4 x0[4], x1[4];
#pragma unroll
        for (int i = 0; i < 4; ++i) {
            const int col = (lane + 64 * i) * 8;
            o[i] = __builtin_nontemporal_load((const u32x4*)(OB + (size_t)row * 2048 + col));
            x0[i] = __builtin_nontemporal_load((const f32x4*)(xr + col)); x1[i] = __builtin_nontemporal_load((const f32x4*)(xr + col + 4));
        }
#pragma unroll
        for (int of = 32; of >= 1; of >>= 1) ss += __shfl_xor(ss, of);
        const float rs = rsqrtf(ss * (1.0f / 2048.0f) + EPS);
#pragma unroll
        for (int i = 0; i < 4; ++i) {
            const int col = (lane + 64 * i) * 8;
            const f32x4 g0 = gA[i], g1 = gB[i];
            f32x4 y0, y1;
            y0[0] = x0[i][0] + bf_lo(o[i].x) * rs * g0[0]; y0[1] = x0[i][1] + bf_hi(o[i].x) * rs * g0[1]; y0[2] = x0[i][2] + bf_lo(o[i].y) * rs * g0[2]; y0[3] = x0[i][3] + bf_hi(o[i].y) * rs * g0[3];
            y1[0] = x1[i][0] + bf_lo(o[i].z) * rs * g1[0]; y1[1] = x1[i][1] + bf_hi(o[i].z) * rs * g1[1]; y1[2] = x1[i][2] + bf_lo(o[i].w) * rs * g1[2]; y1[3] = x1[i][3] + bf_hi(o[i].w) * rs * g1[3];
            __builtin_nontemporal_store(y0, (f32x4*)(yr + col)); __builtin_nontemporal_store(y1, (f32x4*)(yr + col + 4));
        }
    }
}

__device__ __forceinline__ void p6_final(const Params& p) {
    const int tid = threadIdx.x, lane = tid & 63, gw = (int)blockIdx.x * 8 + (tid >> 6);
    const int row = MP + (gw >> 1), half = gw & 1;
    if (row >= MT) return;
    const bf16_t* OB = (const bf16_t*)(p.ws + WS_OUTB);
    const float* OSS = (const float*)(p.ws + WS_OSS);
    const float* gpost = p.in[5];
    const float* xr = p.in[1] + (size_t)(row - MP) * 2048;
    float* yr = p.out + O_Y + (size_t)row * 2048;
    float ss = (lane < 32) ? OSS[(size_t)row * 32 + lane] : 0.f;
    u32x4 o[2]; f32x4 x0[2], x1[2], g0[2], g1[2];
#pragma unroll
    for (int i = 0; i < 2; ++i) {
        const int col = (lane + 64 * (2 * half + i)) * 8;
        o[i] = __builtin_nontemporal_load((const u32x4*)(OB + (size_t)row * 2048 + col));
        x0[i] = __builtin_nontemporal_load((const f32x4*)(xr + col)); x1[i] = __builtin_nontemporal_load((const f32x4*)(xr + col + 4));
        g0[i] = *(const f32x4*)(gpost + col); g1[i] = *(const f32x4*)(gpost + col + 4);
    }
#pragma unroll
    for (int of = 32; of >= 1; of >>= 1) ss += __shfl_xor(ss, of);
    const float rs = rsqrtf(ss * (1.0f / 2048.0f) + EPS);
#pragma unroll
    for (int i = 0; i < 2; ++i) {
        const int col = (lane + 64 * (2 * half + i)) * 8;
        f32x4 y0, y1;
        y0[0] = x0[i][0] + bf_lo(o[i].x) * rs * g0[i][0]; y0[1] = x0[i][1] + bf_hi(o[i].x) * rs * g0[i][1]; y0[2] = x0[i][2] + bf_lo(o[i].y) * rs * g0[i][2]; y0[3] = x0[i][3] + bf_hi(o[i].y) * rs * g0[i][3];
        y1[0] = x1[i][0] + bf_lo(o[i].z) * rs * g1[i][0]; y1[1] = x1[i][1] + bf_hi(o[i].z) * rs * g1[i][1]; y1[2] = x1[i][2] + bf_lo(o[i].w) * rs * g1[i][2]; y1[3] = x1[i][3] + bf_hi(o[i].w) * rs * g1[i][3];
        __builtin_nontemporal_store(y0, (f32x4*)(yr + col)); __builtin_nontemporal_store(y1, (f32x4*)(yr + col + 4));
    }
}

constexpr int LDS_BYTES = pg8::STAGE_BYTES + 16;
__global__ void __launch_bounds__(512, 2) hymba_fwd(Params p) {
    extern __shared__ __attribute__((aligned(16))) unsigned char shm[];
    LAS unsigned char* lds = (LAS unsigned char*)shm;
    const int lo = p.ph_lo, hi = p.ph_hi;
    XcdBarrier bar; bar.bar = nullptr; bar.x = 0; bar.st = nullptr;
    if (hi - lo > 1) {
        volatile LAS unsigned* st = (volatile LAS unsigned*)(lds + pg8::STAGE_BYTES);
        if (threadIdx.x == 0) { st[0] = 0u; st[1] = 0u; st[2] = 0u; }
        __syncthreads();
        bar = xcd_barrier_post((unsigned*)(p.ws + WS_BAR), st);
    }
#define IN(k) (lo <= (k) && (k) < hi)
#define SEAM(k) do { if (IN(k) && IN((k) + 1)) xcd_barrier(bar); } while (0)
    if (IN(0)) { p0_prep(p, lds); }
    SEAM(0);
    if (IN(1)) {
        pg8::Gemm g{(const bf16_t*)(p.ws + WS_ZB), (const bf16_t*)(p.ws + WS_BT1), MT, PW, 2048};
        pg8::StaticOrder S; S.init(MT, PW, (int)gridDim.x, (int)blockIdx.x);
        pg8::EpiProj E{(bf16_t*)(p.ws + WS_SEC), (float*)(p.ws + WS_VSS)};
        pg8::gemm_phase<pg8::EpiProj, pg8::StaticOrder>(lds, g, S, E);
        if (gridDim.x == 256 && blockIdx.x >= 208) {
            convert_small_weights(p, ((int)blockIdx.x - 208) * 512 + (int)threadIdx.x, 48 * 512);
            convert_weights(p, CVT_NT1, CVT_NT1 + CVT_NT2, ((int)blockIdx.x - 208) * 8 + (int)(threadIdx.x >> 6), 48 * 8);
        }
    }
    SEAM(1);
    if (IN(2)) {
        if (gridDim.x == 256) {
            const int grp = blockIdx.x >> 6, bl = blockIdx.x & 63;
            const int nL = grp == 0 ? 2 : grp == 1 ? 1 : grp == 2 ? 3 : 2, L0 = grp == 0 ? 0 : grp == 1 ? 128 : grp == 2 ? 192 : 384;
            const int nS = grp == 0 ? 3 : grp == 1 ? 4 : 1, S0 = grp == 0 ? 0 : grp == 1 ? 192 : grp == 2 ? 448 : 512;
            lru_run<LRU_FUSED ? 2 : 0>(p, lds, L0 + bl, nL, 64, 0);
            sgu_run(p, lds, S0 + bl, nS, 64);
            if (grp == 3) { __syncthreads(); lru_run<1>(p, lds, bl, 1, 0, NGRP_P); }
        } else {
            const int nu = NGRP_P * 8 + NGRP * 8 + (NGRP - NGRP_P) * 8;
            int nsgu = 0;
            for (int u = blockIdx.x; u < nu; u += gridDim.x) {
                if (u < NGRP_P * 8) { __syncthreads(); lru_run<LRU_FUSED ? 2 : 0>(p, lds, u, 1, 0, 0); }
                else if (u < NGRP_P * 8 + NGRP * 8) { const int v = u - NGRP_P * 8; __syncthreads(); sgu_run(p, lds, v, 1, 0); }
                else { const int v = u - NGRP_P * 8 - NGRP * 8; __syncthreads(); lru_run<1>(p, lds, v, 1, 0, NGRP_P); }
            }
        }
    }
    SEAM(2);
#if !LRU_FUSED
    if (IN(3)) {
        for (int u = blockIdx.x; u < NGRP_P * 8; u += gridDim.x) lru_pass2_unit(p, lds, u >> 3, u & 7);
    }
    SEAM(3);
#endif
#if N_LAUNCHES == 1
    if (IN(4) && IN(5)) {
        pg8::Gemm g{(const bf16_t*)(p.ws + WS_A2), (const bf16_t*)(p.ws + WS_BT2), MT, 2048, 2048};
        pg8::OrderG2 S{(int)blockIdx.x, bar, (LAS unsigned*)(lds + pg8::STAGE_BYTES + 8)};
        pg8::EpiOut E{(bf16_t*)(p.ws + WS_OUTB), (float*)(p.ws + WS_OSS)};
        pg8::gemm_phase<pg8::EpiOut, pg8::OrderG2>(lds, g, S, E);
        if (blockIdx.x >= 32) { xcd_barrier(bar); p5_final(p, 0, MP, (int)blockIdx.x - 32, (int)gridDim.x - 32); }
        xcd_barrier(bar);
    }
#else
#pragma unroll 1
    for (int rd = 0; rd < 2; ++rd) {
        if (IN(4 + rd)) {
            if (rd == 0 || blockIdx.x < 32 || gridDim.x <= 32) {
                pg8::Gemm g{(const bf16_t*)(p.ws + WS_A2), (const bf16_t*)(p.ws + WS_BT2), MT, 2048, 2048};
                pg8::Order2 S{rd, (int)blockIdx.x};
                pg8::EpiOut E{(bf16_t*)(p.ws + WS_OUTB), (float*)(p.ws + WS_OSS)};
                pg8::gemm_phase<pg8::EpiOut, pg8::Order2>(lds, g, S, E);
            }
            if (rd == 1 && blockIdx.x >= 32) p5_final(p, 0, MP, (int)blockIdx.x - 32, (int)gridDim.x - 32);
        }
        SEAM(4 + rd);
    }
#endif
    if (IN(6)) { if (gridDim.x == 256) p6_final(p); else p5_final(p, MP, MT, (int)blockIdx.x, (int)gridDim.x); }
#undef IN
#undef SEAM
}

extern "C" void kernel_launch(void* const* d_in, const int* in_sizes, int n_in, void* d_out, int out_size, void* d_ws, size_t ws_size, hipStream_t stream) {
    static int grid = 0;
    if (grid == 0) {
        int dev = 0, cus = 0, per_cu = 0;
        if (n_in != 18 || ws_size < WS_END) { fprintf(stderr, "kernel_launch: unexpected problem (n_in %d, ws %zu < %zu)\n", n_in, ws_size, (size_t)WS_END); grid = -1; return; }
        hipGetDevice(&dev);
        hipDeviceGetAttribute(&cus, hipDeviceAttributeMultiprocessorCount, dev);
        if (hipFuncSetAttribute((const void*)hymba_fwd, hipFuncAttributeMaxDynamicSharedMemorySize, LDS_BYTES) != hipSuccess) { fprintf(stderr, "kernel_launch: hipFuncSetAttribute failed\n"); grid = -1; return; }
        hipOccupancyMaxActiveBlocksPerMultiprocessor(&per_cu, (const void*)hymba_fwd, 512, LDS_BYTES);
        if (per_cu < 1) { fprintf(stderr, "kernel_launch: occupancy query says %d blocks per CU\n", per_cu); per_cu = 1; }
        (void)hipGetLastError();
        grid = cus;
    }
    if (grid < 0) return;
    Params p{};
    for (int i = 0; i < 18; ++i) p.in[i] = (const float*)d_in[i];
    const size_t ws_shift = (ws_size - WS_END) & ~(size_t)((2u << 20) - 1);
    p.out = (float*)d_out; p.ws = (unsigned char*)d_ws + ws_shift;
#if N_LAUNCHES == 1
    p.ph_lo = 0; p.ph_hi = 7;
    if (hipMemsetAsync((char*)p.ws + WS_BAR, 0, WS_END - WS_BAR, stream) != hipSuccess) { fprintf(stderr, "kernel_launch: memset of the barrier words / scan granules failed\n"); return; }
    hipLaunchKernelGGL(hymba_fwd, dim3(grid), dim3(512), LDS_BYTES, stream, p);
#else
#ifndef PROBE_SEQ
#define PROBE_SEQ {0, 1, 2, 3, 4, 5, 6}
#endif
    const int seq[] = PROBE_SEQ;
    for (int k : seq) {
        p.ph_lo = k; p.ph_hi = k + 1;
        hipLaunchKernelGGL(hymba_fwd, dim3(grid), dim3(512), LDS_BYTES, stream, p);
    }
#endif
}
```
